# Optimizing an MI355X kernel written in HIP

```python
import math
import jax, jax.numpy as jnp
from jax import lax
import numpy as np

D_MODEL = 2048
BATCH = 2
SEQ = 8192
DEPTH = 4

HEAD_DIM = 128
N_GROUP_HEADS = D_MODEL // HEAD_DIM
SGU_GROUPS = N_GROUP_HEADS // 4
RET_HEADS = (N_GROUP_HEADS - SGU_GROUPS) // 2
DIFF_HEADS = N_GROUP_HEADS - SGU_GROUPS - RET_HEADS
DIFF_MAP_DIM = HEAD_DIM // 2
RET_W = RET_HEADS * HEAD_DIM
DIFF_W = DIFF_HEADS * HEAD_DIM
SGU_W = SGU_GROUPS * HEAD_DIM
SGU_GROUP_DIM = SGU_W // SGU_GROUPS
IN_W = 4 * RET_W + 3 * DIFF_W + 2 * SGU_W
CHUNK = 128
FFN_HIDDEN = -(-8 * D_MODEL // (3 * 256)) * 256
EPS = 1e-6

kernel_name = "hybrid_retention_diffattn_sgu_block"


def rms_norm(x, g):
    xf = x.astype(jnp.float32)
    y = xf * lax.rsqrt(jnp.mean(xf * xf, axis=-1, keepdims=True) + EPS)
    return (y * g.astype(jnp.float32)).astype(x.dtype)


def retention(q, k, v, gate, gn_gain):
    B, T, _ = q.shape
    N = T // CHUNK
    H, d = RET_HEADS, HEAD_DIM
    log_gamma = jnp.log1p(-(2.0 ** (-5.0 - jnp.arange(H, dtype=jnp.float32))))

    def chunks(a):
        return a.astype(jnp.float32).reshape(B, N, CHUNK, H, d).transpose(1, 0, 3, 2, 4)

    qc = chunks(q)
    kc = chunks(k) * (d ** -0.5)
    vc = chunks(v)
    pos = jnp.arange(CHUNK, dtype=jnp.float32)
    rel = pos[:, None] - pos[None, :]
    decay = jnp.where(rel >= 0, jnp.exp(log_gamma[:, None, None] * jnp.maximum(rel, 0.0)), 0.0)
    scores = jnp.einsum('nbhcd,nbhed->nbhce', qc, kc) * decay
    inner = jnp.einsum('nbhce,nbhed->nbhcd', scores, vc)
    zeta = jnp.exp(log_gamma[:, None] * (CHUNK - 1.0 - pos))
    xi = jnp.exp(log_gamma[:, None] * (pos + 1.0))
    kv = jnp.einsum('nbhcd,nbhce->nbhde', kc * zeta[:, :, None], vc)
    chunk_decay = jnp.exp(log_gamma * CHUNK)[:, None, None]

    def step(R, kv_i):
        return kv_i + chunk_decay * R, R

    _, R_prev = lax.scan(step, jnp.zeros((B, H, d, d), jnp.float32), kv)
    cross = jnp.einsum('nbhcd,nbhde->nbhce', qc, R_prev) * xi[:, :, None]
    y = (inner + cross).transpose(1, 0, 3, 2, 4).reshape(B, T, H, d)
    mu = jnp.mean(y, axis=-1, keepdims=True)
    var = jnp.mean(jnp.square(y - mu), axis=-1, keepdims=True)
    y = (y - mu) * lax.rsqrt(var + EPS) * gn_gain.astype(jnp.float32)
    out = jax.nn.silu(gate.astype(jnp.float32)).reshape(B, T, H, d) * y
    return out.reshape(B, T, RET_W).astype(q.dtype)


def diff_attention(q, k, v, lam_q1, lam_k1, lam_q2, lam_k2, subln_gain, lambda_init):
    B, T, _ = q.shape
    H, dm, dv = DIFF_HEADS, DIFF_MAP_DIM, HEAD_DIM
    NB = T // CHUNK
    qf = q.astype(jnp.float32).reshape(B, T, H, 2, dm) * (dm ** -0.5)
    kt = k.astype(jnp.float32).reshape(B, T, H, 2, dm).transpose(0, 2, 3, 1, 4)
    vt = v.astype(jnp.float32).reshape(B, T, H, dv).transpose(0, 2, 1, 3)
    qb = qf.reshape(B, NB, CHUNK, H, 2, dm).transpose(1, 0, 3, 4, 2, 5)
    lam = (jnp.exp(jnp.sum(lam_q1.astype(jnp.float32) * lam_k1.astype(jnp.float32)))
           - jnp.exp(jnp.sum(lam_q2.astype(jnp.float32) * lam_k2.astype(jnp.float32)))
           + lambda_init)
    slopes = 2.0 ** (-8.0 * jnp.arange(1, H + 1, dtype=jnp.float32) / H)
    key_pos = jnp.arange(T)

    def block(args):
        q_blk, start = args
        qpos = start + jnp.arange(CHUNK)
        dist = (qpos[:, None] - key_pos[None, :]).astype(jnp.float32)
        s = jnp.einsum('bhmcd,bhmtd->bhmct', q_blk, kt) - slopes[None, :, None, None, None] * dist
        s = jnp.where(dist >= 0, s, -jnp.inf)
        p = jax.nn.softmax(s, axis=-1)
        a = p[:, :, 0] - lam * p[:, :, 1]
        return jnp.einsum('bhct,bhte->bhce', a, vt)

    starts = jnp.arange(NB) * CHUNK
    o = lax.map(block, (qb, starts))
    o = o.transpose(1, 0, 3, 2, 4).reshape(B, T, H, dv)
    o = o * lax.rsqrt(jnp.mean(o * o, axis=-1, keepdims=True) + EPS) * subln_gain.astype(jnp.float32)
    o = o * (1.0 - lambda_init)
    return o.reshape(B, T, DIFF_W).astype(q.dtype)


def spatial_gating(u, v, ln_g, ln_b, w_s, b_s):
    B, T, _ = u.shape
    N = T // CHUNK
    G, dg = SGU_GROUPS, SGU_GROUP_DIM
    uf = jax.nn.gelu(u.astype(jnp.float32)).reshape(B, N, CHUNK, G, dg)
    vf = jax.nn.gelu(v.astype(jnp.float32)).reshape(B, N, CHUNK, G, dg)
    mu = jnp.mean(vf, axis=-1, keepdims=True)
    var = jnp.mean(jnp.square(vf - mu), axis=-1, keepdims=True)
    vf = (vf - mu) * lax.rsqrt(var + EPS) * ln_g.astype(jnp.float32) + ln_b.astype(jnp.float32)
    mask = jnp.tril(jnp.ones((CHUNK, CHUNK), jnp.float32))
    w = w_s.astype(jnp.float32) * mask
    mixed = jnp.einsum('gts,bnsgd->bntgd', w, vf) + b_s.astype(jnp.float32).T[None, None, :, :, None]
    return (uf * mixed).reshape(B, T, SGU_W).astype(u.dtype)


def setup_inputs(seed: int = 0) -> dict:
    key = jax.random.key(seed)
    ks = jax.random.split(key, 24)
    f32 = jnp.float32
    L, D = DEPTH, D_MODEL

    def nrm(k, shape, scale):
        return jax.random.normal(k, shape, f32) * scale

    def gain(k, shape):
        return 1.0 + 0.05 * jax.random.normal(k, shape, f32)

    return {
        "x": jax.random.normal(ks[0], (BATCH, SEQ, D), f32),
        "pre_mix_g": gain(ks[1], (L, D)),
        "w_in": nrm(ks[2], (L, D, IN_W), D ** -0.5),
        "ret_gn_g": gain(ks[3], (L, RET_HEADS, HEAD_DIM)),
        "diff_lam_q1": nrm(ks[4], (L, DIFF_MAP_DIM), 0.1),
        "diff_lam_k1": nrm(ks[5], (L, DIFF_MAP_DIM), 0.1),
        "diff_lam_q2": nrm(ks[6], (L, DIFF_MAP_DIM), 0.1),
        "diff_lam_k2": nrm(ks[7], (L, DIFF_MAP_DIM), 0.1),
        "diff_subln_g": gain(ks[8], (L, DIFF_HEADS, HEAD_DIM)),
        "sgu_ln_g": gain(ks[9], (L, SGU_GROUPS, SGU_GROUP_DIM)),
        "sgu_ln_b": nrm(ks[10], (L, SGU_GROUPS, SGU_GROUP_DIM), 0.02),
        "sgu_w": nrm(ks[11], (L, SGU_GROUPS, CHUNK, CHUNK), CHUNK ** -0.5),
        "sgu_b": 1.0 + nrm(ks[12], (L, SGU_GROUPS, CHUNK), 0.1),
        "w_out": nrm(ks[13], (L, D, D), D ** -0.5),
        "post_mix_g": gain(ks[14], (L, D)),
        "pre_ffn_g": gain(ks[15], (L, D)),
        "w_gate": nrm(ks[16], (L, D, FFN_HIDDEN), D ** -0.5),
        "w_up": nrm(ks[17], (L, D, FFN_HIDDEN), D ** -0.5),
        "w_down": nrm(ks[18], (L, FFN_HIDDEN, D), FFN_HIDDEN ** -0.5),
        "post_ffn_g": gain(ks[19], (L, D)),
    }


def reference(x, pre_mix_g, w_in, ret_gn_g, diff_lam_q1, diff_lam_k1, diff_lam_q2, diff_lam_k2,
              diff_subln_g, sgu_ln_g, sgu_ln_b, sgu_w, sgu_b, w_out, post_mix_g, pre_ffn_g,
              w_gate, w_up, w_down, post_ffn_g):
    split_points = [RET_W, 2 * RET_W, 3 * RET_W, 4 * RET_W,
                    4 * RET_W + DIFF_W, 4 * RET_W + 2 * DIFF_W, 4 * RET_W + 3 * DIFF_W,
                    4 * RET_W + 3 * DIFF_W + SGU_W]
    for l in range(DEPTH):
        lambda_init = 0.8 - 0.6 * math.exp(-0.3 * l)
        h = rms_norm(x, pre_mix_g[l])
        proj = h @ w_in[l]
        rq, rk, rv, rg, dq, dk, dv, su, sv = jnp.split(proj, split_points, axis=-1)
        y_ret = retention(rq, rk, rv, rg, ret_gn_g[l])
        y_diff = diff_attention(dq, dk, dv, diff_lam_q1[l], diff_lam_k1[l], diff_lam_q2[l],
                                diff_lam_k2[l], diff_subln_g[l], lambda_init)
        y_sgu = spatial_gating(su, sv, sgu_ln_g[l], sgu_ln_b[l], sgu_w[l], sgu_b[l])
        mix = jnp.concatenate([y_ret, y_diff, y_sgu], axis=-1) @ w_out[l]
        x = x + rms_norm(mix, post_mix_g[l])
        h = rms_norm(x, pre_ffn_g[l])
        f = (jax.nn.silu(h @ w_gate[l]) * (h @ w_up[l])) @ w_down[l]
        x = x + rms_norm(f, post_ffn_g[l])
    return x
```

```cpp
#include <hip/hip_runtime.h>
#include <hip/hip_cooperative_groups.h>
#include <hip/hip_bf16.h>
#include <cstdio>
#include <cstdint>
#include <cmath>
namespace pg8 {
#define PG8_LAS __attribute__((address_space(3)))
typedef unsigned short bf16_t;
typedef short bf16x8 __attribute__((ext_vector_type(8)));
typedef float f32x4 __attribute__((ext_vector_type(4)));
typedef unsigned u32x4 __attribute__((ext_vector_type(4)));
constexpr int BM = 256, BK = 64, HALF = 128, HTB = HALF * BK * 2  , STAGE_BYTES = 8 * HTB, NXCD = 8, WGM = 8;

__host__ __device__ __forceinline__ int lds_byte(int r, int c) { const int st = (r >> 4) * 2 + (c >> 5), rr = r & 15, cc = c & 31, ob = rr * 64 + cc * 2; return st * 1024 + (ob ^ (((ob >> 9) & 1) << 5)); }
__host__ __device__ __forceinline__ void stage_rc(int b, int& R, int& C) { const int st = b / 1024, sb = b % 1024, swz = sb ^ (((sb >> 9) & 1) << 5); R = (st >> 1) * 16 + swz / 64; C = (st & 1) * 32 + (swz % 64) / 2; }
__host__ __device__ __forceinline__ int perm32(int rho) { const int n = rho >> 4, i = rho & 15; return 8 * (i >> 2) + 4 * n + (i & 3); }

struct Unit { int pm, pn; };
struct Gemm { const bf16_t* A; const bf16_t* Bt; int M, N, K; };

struct StaticOrder {
    int nM, nN, nwg, G, c;
    __host__ __device__ void init(int M, int N, int G_, int c_) { nM = M / BM; nN = N / BM; nwg = nM * nN; G = G_; c = c_; }
    __host__ __device__ bool next(int i, Unit& u) const {
        const long L = (long)i * G + c; if (L >= nwg) return false;
        int wgid = (int)L; { const int q = nwg / NXCD, r = nwg % NXCD, xcd = wgid % NXCD, off = wgid / NXCD; wgid = (xcd < r ? xcd * (q + 1) : r * (q + 1) + (xcd - r) * q) + off; }
        const int nig = WGM * nN, gid = wgid / nig, fm = gid * WGM, gsz = (nM - fm) < WGM ? (nM - fm) : WGM;
        u.pm = fm + ((wgid % nig) % gsz); u.pn = (wgid % nig) / gsz; return true;
    }
    __device__ __forceinline__ void a_ready(const Unit&) const {}
    __device__ __forceinline__ void done(const Unit&) const {}
};

typedef float f32x2c_t __attribute__((ext_vector_type(2))); typedef __bf16 bf16x2c_t __attribute__((ext_vector_type(2)));
__device__ __forceinline__ unsigned cvt_pk_bf16(float lo, float hi) { f32x2c_t v = {lo, hi}; bf16x2c_t b = __builtin_convertvector(v, bf16x2c_t); return __builtin_bit_cast(unsigned, b); }
typedef float f32x2 __attribute__((ext_vector_type(2)));
struct OneUnit {
    int pm, pn;
    __device__ __forceinline__ bool next(int i, Unit& u) const { if (i) return false; u.pm = pm; u.pn = pn; return true; }
    __device__ __forceinline__ void a_ready(const Unit&) const {}
    __device__ __forceinline__ void done(const Unit&) const {}
};
struct EpiProj {
    static constexpr bool PERM = true, AFTER_DRAIN = false;
    bf16_t* O; int ldc; const float* rs;
    __device__ __forceinline__ void operator()(const f32x4 (&acc)[2][2][4][2], const Unit& u, int wr, int wc, int fr, int fq) const {
        const float sc0 = (u.pn >= 3 && u.pn < 6) ? 0.08838834764831845f : ((u.pn >= 12 && u.pn < 15) ? 0.125f * 1.4426950408889634f : 1.f);
        const int row0 = u.pm * BM + wr * 64 + fr, col0 = u.pn * BM + wc * 32 + 8 * fq;
#pragma unroll
        for (int ai = 0; ai < 2; ++ai)
#pragma unroll
            for (int m = 0; m < 4; ++m) { bf16_t* rowp = O + (size_t)(row0 + ai * HALF + m * 16) * ldc + col0; const float sc = sc0 * rs[row0 + ai * HALF + m * 16];
#pragma unroll
                for (int bj = 0; bj < 2; ++bj) { const f32x4 v0 = acc[ai][bj][m][0] * sc, v1 = acc[ai][bj][m][1] * sc;
                    u32x4 w; w.x = cvt_pk_bf16(v0[0], v0[1]); w.y = cvt_pk_bf16(v0[2], v0[3]); w.z = cvt_pk_bf16(v1[0], v1[1]); w.w = cvt_pk_bf16(v1[2], v1[3]);
                    *(u32x4*)(rowp + bj * HALF) = w; } }
    }
};
struct EpiBf {
    static constexpr bool PERM = true, AFTER_DRAIN = false;
    bf16_t* O; int ldc;
    __device__ __forceinline__ void operator()(const f32x4 (&acc)[2][2][4][2], const Unit& u, int wr, int wc, int fr, int fq) const {
        const int row0 = u.pm * BM + wr * 64 + fr, col0 = u.pn * BM + wc * 32 + 8 * fq;
#pragma unroll
        for (int ai = 0; ai < 2; ++ai)
#pragma unroll
            for (int m = 0; m < 4; ++m) { bf16_t* rowp = O + (size_t)(row0 + ai * HALF + m * 16) * ldc + col0;
#pragma unroll
                for (int bj = 0; bj < 2; ++bj) { const f32x4 v0 = acc[ai][bj][m][0], v1 = acc[ai][bj][m][1];
                    u32x4 w; w.x = cvt_pk_bf16(v0[0], v0[1]); w.y = cvt_pk_bf16(v0[2], v0[3]); w.z = cvt_pk_bf16(v1[0], v1[1]); w.w = cvt_pk_bf16(v1[2], v1[3]);
                    *(u32x4*)(rowp + bj * HALF) = w; } }
    }
};
struct EpiF32 {
    static constexpr bool PERM = false, AFTER_DRAIN = false;
    float* O; int ldc;
    __device__ __forceinline__ void operator()(const f32x4 (&acc)[2][2][4][2], const Unit& u, int wr, int wc, int fr, int fq) const {
        const int col0 = u.pn * BM + wc * 32 + 4 * fq;
#pragma unroll
        for (int ai = 0; ai < 2; ++ai)
#pragma unroll
            for (int m = 0; m < 4; ++m) { float* rowp = O + (size_t)(u.pm * BM + ai * HALF + wr * 64 + m * 16 + fr) * ldc + col0;
#pragma unroll
                for (int bj = 0; bj < 2; ++bj)
#pragma unroll
                    for (int n = 0; n < 2; ++n) *(f32x4*)(rowp + bj * HALF + n * 16) = acc[ai][bj][m][n]; }
    }
};
struct EpiSwiGLU {
    static constexpr bool PERM = true, AFTER_DRAIN = false;
    bf16_t* O; int ldc; const float* rs;
    __device__ __forceinline__ static float sw(float g, float u) { return g * __builtin_amdgcn_rcpf(1.f + __builtin_amdgcn_exp2f(-1.4426950408889634f * g)) * u; }
    __device__ __forceinline__ void operator()(const f32x4 (&acc)[2][2][4][2], const Unit& u, int wr, int wc, int fr, int fq) const {
        const int row0 = u.pm * BM + wr * 64 + fr, col0 = u.pn * HALF + wc * 32 + 8 * fq;
#pragma unroll
        for (int ai = 0; ai < 2; ++ai)
#pragma unroll
            for (int m = 0; m < 4; ++m) { bf16_t* rowp = O + (size_t)(row0 + ai * HALF + m * 16) * ldc + col0;
                const float r_ = rs[row0 + ai * HALF + m * 16];
                const f32x4 g0 = acc[ai][0][m][0] * r_, g1 = acc[ai][0][m][1] * r_, u0 = acc[ai][1][m][0] * r_, u1 = acc[ai][1][m][1] * r_;
                u32x4 w; w.x = cvt_pk_bf16(sw(g0[0], u0[0]), sw(g0[1], u0[1])); w.y = cvt_pk_bf16(sw(g0[2], u0[2]), sw(g0[3], u0[3]));
                w.z = cvt_pk_bf16(sw(g1[0], u1[0]), sw(g1[1], u1[1])); w.w = cvt_pk_bf16(sw(g1[2], u1[2]), sw(g1[3], u1[3]));
                *(u32x4*)rowp = w; }
    }
};

template <class Epi, class Sched, bool ALIGN_EPI = false, bool SP2 = false>
__device__ __forceinline__ void gemm_phase(PG8_LAS unsigned char* lds, const Gemm g, const Sched& S, const Epi& E) {
    int tid = threadIdx.x; asm volatile("" : "+v"(tid)); const int wid = __builtin_amdgcn_readfirstlane(tid >> 6), lane = tid & 63, wr = wid >> 2, wc = wid & 3, fr = lane & 15, fq = lane >> 4;
    const int K = g.K, nt = K / BK;
    unsigned voffA[2], voffB[2];
#pragma unroll
    for (int i = 0; i < 2; ++i) { int R, C; stage_rc(tid * 16 + i * 8192, R, C); const int Rb = Epi::PERM ? ((R & ~31) + perm32(R & 31)) : R;
        voffA[i] = (unsigned)(R * K + C) * 2u; voffB[i] = (unsigned)(Rb * K + C) * 2u; }
    const size_t kstep = (size_t)(BK * 2);
    const size_t hstep = (size_t)HALF * K * 2;
    const size_t tstep = 2 * hstep;
    const unsigned ldsw = (unsigned)wid * 1024u;
    const int aoff = lds_byte(wr * 64 + fr, fq * 8), boff = lds_byte(wc * 32 + fr, fq * 8);
#define PG8_SA(b, h) (((b) * 2 + (h)) * HTB)
#define PG8_SB(b, h) ((4 + (b) * 2 + (h)) * HTB)
#define PG8_STAGE(bufoff, gbase, voff) do { _Pragma("unroll") for (int _i = 0; _i < 2; ++_i) \
        __builtin_amdgcn_global_load_lds((const unsigned*)((const char*)(gbase) + (voff)[_i]), (PG8_LAS unsigned*)(lds + (bufoff) + ldsw + _i * 8192), 16, 0, 0); } while (0)
#define PG8_LDA(dst, b, h) do { _Pragma("unroll") for (int m = 0; m < 4; ++m) _Pragma("unroll") for (int k = 0; k < 2; ++k) dst[m][k] = *(const PG8_LAS bf16x8*)(lds + PG8_SA(b, h) + aoff + m * 2048 + k * 1024); } while (0)
#define PG8_LDB(dst, b, h) do { _Pragma("unroll") for (int n = 0; n < 2; ++n) _Pragma("unroll") for (int k = 0; k < 2; ++k) dst[n][k] = *(const PG8_LAS bf16x8*)(lds + PG8_SB(b, h) + boff + n * 2048 + k * 1024); } while (0)
#define PG8_MMA(ai, bj, At, Bt) do { __builtin_amdgcn_s_setprio(1); _Pragma("unroll") for (int m = 0; m < 4; ++m) _Pragma("unroll") for (int n = 0; n < 2; ++n) _Pragma("unroll") for (int k = 0; k < 2; ++k) \
        acc[ai][bj][m][n] = __builtin_amdgcn_mfma_f32_16x16x32_bf16(Bt[n][k], At[m][k], acc[ai][bj][m][n], 0, 0, 0); __builtin_amdgcn_s_setprio(0); } while (0)
#define PG8_WAIT_V(n) asm volatile("s_waitcnt vmcnt(" #n ")" ::: "memory")
#define PG8_WAIT_L(n) asm volatile("s_waitcnt lgkmcnt(" #n ")" ::: "memory")
#define PG8_BAR __builtin_amdgcn_s_barrier()
#define PG8_SCHED __builtin_amdgcn_sched_barrier(0)
    Unit cur, nxt; int ui = 0;
    if (!S.next(0, cur)) return;
    f32x4 acc[2][2][4][2];
#pragma unroll
    for (int a = 0; a < 2; ++a)
#pragma unroll
        for (int b = 0; b < 2; ++b)
#pragma unroll
            for (int m = 0; m < 4; ++m)
#pragma unroll
                for (int n = 0; n < 2; ++n) acc[a][b][m][n] = (f32x4){0.f, 0.f, 0.f, 0.f};
    bf16x8 At[4][2], B0[2][2], B1[2][2];
    const char* cA = (const char*)g.A + (size_t)cur.pm * tstep; const char* cB = (const char*)g.Bt + (size_t)cur.pn * tstep;
    S.a_ready(cur);
    if constexpr (SP2) {
        PG8_STAGE(PG8_SB(0, 0), cB, voffB); PG8_STAGE(PG8_SB(0, 1), cB + hstep, voffB); PG8_STAGE(PG8_SA(0, 0), cA, voffA); PG8_STAGE(PG8_SA(0, 1), cA + hstep, voffA);
        if (wr == 1) PG8_BAR;
        PG8_WAIT_V(2); PG8_BAR;
        PG8_STAGE(PG8_SB(1, 0), cB + kstep, voffB); PG8_STAGE(PG8_SA(1, 0), cA + kstep, voffA); PG8_STAGE(PG8_SB(1, 1), cB + hstep + kstep, voffB);
        PG8_WAIT_V(6); PG8_BAR;
    } else {
        PG8_STAGE(PG8_SB(0, 0), cB, voffB); PG8_STAGE(PG8_SA(0, 0), cA, voffA); PG8_STAGE(PG8_SB(0, 1), cB + hstep, voffB); PG8_STAGE(PG8_SA(0, 1), cA + hstep, voffA);
        if (wr == 1) PG8_BAR;
        PG8_WAIT_V(4); PG8_BAR;
        PG8_STAGE(PG8_SB(1, 0), cB + kstep, voffB); PG8_STAGE(PG8_SA(1, 0), cA + kstep, voffA); PG8_STAGE(PG8_SB(1, 1), cB + hstep + kstep, voffB);
        PG8_WAIT_V(6); PG8_BAR;
    }
    for (;;) {
        const bool has_next = S.next(ui + 1, nxt);
        const char* nA = has_next ? (const char*)g.A + (size_t)nxt.pm * tstep : cA; const char* nB = has_next ? (const char*)g.Bt + (size_t)nxt.pn * tstep : cB;
        for (int t = 0; t < nt; t += 2) {
            const bool last = (t == nt - 2);
            const char* a1 = cA + (size_t)(t + 1) * kstep;
            const char* a2 = last ? nA : cA + (size_t)(t + 2) * kstep; const char* b2 = last ? nB : cB + (size_t)(t + 2) * kstep;
            const char* a3 = a2 + kstep; const char* b3 = b2 + kstep;
            if (last && has_next) S.a_ready(nxt);
            if constexpr (SP2) {
            PG8_LDB(B0, 0, 0); PG8_LDB(B1, 0, 1); PG8_SCHED; PG8_LDA(At, 0, 0); PG8_STAGE(PG8_SA(1, 1), a1 + hstep, voffA);
            PG8_WAIT_V(8); PG8_WAIT_L(0); PG8_BAR; PG8_MMA(0, 0, At, B0); PG8_MMA(0, 1, At, B1); PG8_BAR; PG8_SCHED;
            PG8_LDA(At, 0, 1); PG8_STAGE(PG8_SB(0, 0), b2, voffB); PG8_STAGE(PG8_SB(0, 1), b2 + hstep, voffB); PG8_STAGE(PG8_SA(0, 0), a2, voffA);
            PG8_WAIT_V(8); PG8_WAIT_L(0); PG8_BAR; PG8_MMA(1, 0, At, B0); PG8_MMA(1, 1, At, B1); PG8_BAR; PG8_SCHED;
            PG8_LDB(B0, 1, 0); PG8_LDB(B1, 1, 1); PG8_SCHED; PG8_LDA(At, 1, 0); PG8_STAGE(PG8_SA(0, 1), a2 + hstep, voffA);
            PG8_WAIT_V(8); PG8_WAIT_L(0); PG8_BAR; PG8_MMA(0, 0, At, B0); PG8_MMA(0, 1, At, B1); PG8_BAR; PG8_SCHED;
            PG8_LDA(At, 1, 1); PG8_STAGE(PG8_SB(1, 0), b3, voffB); PG8_STAGE(PG8_SB(1, 1), b3 + hstep, voffB); PG8_STAGE(PG8_SA(1, 0), a3, voffA);
            PG8_WAIT_V(8); PG8_WAIT_L(0); PG8_BAR; PG8_MMA(1, 0, At, B0); PG8_MMA(1, 1, At, B1); PG8_BAR; PG8_SCHED;
            } else {
            PG8_LDB(B0, 0, 0); PG8_SCHED; PG8_LDA(At, 0, 0); PG8_STAGE(PG8_SA(1, 1), a1 + hstep, voffA);
            PG8_WAIT_L(8); PG8_BAR; PG8_WAIT_L(0); PG8_MMA(0, 0, At, B0); PG8_BAR; PG8_SCHED;
            PG8_LDB(B1, 0, 1); PG8_STAGE(PG8_SB(0, 0), b2, voffB);
            PG8_BAR; PG8_WAIT_L(0); PG8_MMA(0, 1, At, B1); PG8_BAR;
            PG8_LDA(At, 0, 1); PG8_STAGE(PG8_SA(0, 0), a2, voffA);
            PG8_BAR; PG8_WAIT_L(0); PG8_MMA(1, 0, At, B0); PG8_BAR; PG8_SCHED;
            PG8_STAGE(PG8_SB(0, 1), b2 + hstep, voffB);
            PG8_WAIT_V(6); PG8_BAR; PG8_MMA(1, 1, At, B1); PG8_BAR;
            PG8_LDB(B0, 1, 0); PG8_SCHED; PG8_LDA(At, 1, 0); PG8_STAGE(PG8_SA(0, 1), a2 + hstep, voffA);
            PG8_WAIT_L(8); PG8_BAR; PG8_WAIT_L(0); PG8_MMA(0, 0, At, B0); PG8_BAR; PG8_SCHED;
            PG8_LDB(B1, 1, 1); PG8_STAGE(PG8_SB(1, 0), b3, voffB);
            PG8_BAR; PG8_WAIT_L(0); PG8_MMA(0, 1, At, B1); PG8_BAR;
            PG8_LDA(At, 1, 1); PG8_STAGE(PG8_SA(1, 0), a3, voffA);
            PG8_BAR; PG8_WAIT_L(0); PG8_MMA(1, 0, At, B0); PG8_BAR; PG8_SCHED;
            PG8_STAGE(PG8_SB(1, 1), b3 + hstep, voffB);
            PG8_WAIT_V(6); PG8_BAR; PG8_MMA(1, 1, At, B1); PG8_BAR;
            }
        }
        if constexpr (ALIGN_EPI) { if (wr == 0) PG8_BAR; }
        if constexpr (!Epi::AFTER_DRAIN) { E(acc, cur, wr, wc, fr, fq); S.done(cur); }
        if (!has_next) break;
#pragma unroll
        for (int a = 0; a < 2; ++a)
#pragma unroll
            for (int b = 0; b < 2; ++b)
#pragma unroll
                for (int m = 0; m < 4; ++m)
#pragma unroll
                    for (int n = 0; n < 2; ++n) acc[a][b][m][n] = (f32x4){0.f, 0.f, 0.f, 0.f};
        cur = nxt; cA = nA; cB = nB; ++ui;
        if constexpr (ALIGN_EPI) { if (wr == 1) PG8_BAR; }
    }
    PG8_WAIT_V(0);
    if constexpr (!ALIGN_EPI) { if (wr == 0) PG8_BAR; }
    PG8_BAR;
    if constexpr (Epi::AFTER_DRAIN) { E.fused(acc, cur, wr, wc, fr, fq, lds, wid, lane); S.done(cur); }
#undef PG8_SA
#undef PG8_SB
#undef PG8_STAGE
#undef PG8_LDA
#undef PG8_LDB
#undef PG8_MMA
#undef PG8_WAIT_V
#undef PG8_WAIT_L
#undef PG8_BAR
#undef PG8_SCHED
}
}

namespace attn_body {
using bf16=__hip_bfloat16;
using bf16x8=__attribute__((ext_vector_type(8)))short;
using s16x4=__attribute__((ext_vector_type(4)))short;
using f32x16=__attribute__((ext_vector_type(16)))float;
using u32x4=__attribute__((ext_vector_type(4)))unsigned;
constexpr int BATCH=2,SEQ=8192,D=64,DM=6400;
constexpr int NW=8,QBLK=32,QB=QBLK*NW,KVBLK=64,NQB=SEQ/QB;
constexpr int ATTN_PITCH=DM, ATTN_UNIT_ROWS=QB;
__device__ __forceinline__ int crow(int r,int hi){return (r&3)+8*(r>>2)+4*hi;}
#define SBAR() __builtin_amdgcn_sched_barrier(0)
__device__ __forceinline__ void cmask(f32x16&p0,f32x16&p1,int jb,int qrel,int hi){
  const float NEG=-INFINITY; int kb=64*jb+4*hi;
  #pragma unroll
  for(int r=0;r<16;++r){int kv=kb+(r&3)+8*(r>>2); if(kv>qrel)p0[r]=NEG; if(kv+32>qrel)p1[r]=NEG;}
}

constexpr int NSLOT=3, SLOTB=8192;
constexpr int LDS_K=0, LDS_V=NSLOT*SLOTB, LDS_WS=3*NSLOT*SLOTB, LDS_OST=LDS_WS+NW*64*4, LDS_BYTES=LDS_OST+NW*4096;
constexpr float C2=0.125f*1.4426950408889634f;
__device__ __forceinline__ void glds16(const void*gsrc,unsigned lds_dst){unsigned keep;
  asm volatile("s_mov_b32 %0, m0\n\ts_mov_b32 m0, %2\n\ts_nop 0\n\tglobal_load_lds_dwordx4 %1, off\n\ts_mov_b32 m0, %0":"=&s"(keep):"v"(gsrc),"s"(lds_dst):"memory");}
__device__ __forceinline__ float max3f(float a,float b,float c){float r;asm("v_max3_f32 %0, %1, %2, %3":"=v"(r):"v"(a),"v"(b),"v"(c));return r;}
__device__ __forceinline__ float max2f(float a,float b){float r;asm("v_max_f32_e32 %0, %1, %2":"=v"(r):"v"(a),"v"(b));return r;}
__device__ __forceinline__ float fadd_s(float a,float b){float r;asm("v_add_f32_e32 %0, %1, %2":"=v"(r):"v"(a),"v"(b));return r;}
__device__ __forceinline__ float fsub_s(float a,float b){float r;asm("v_sub_f32_e32 %0, %1, %2":"=v"(r):"v"(a),"v"(b));return r;}
typedef float f32x2_t __attribute__((ext_vector_type(2))); typedef __bf16 bf16x2_t __attribute__((ext_vector_type(2)));
__device__ __forceinline__ unsigned cvtpk_s(float lo,float hi){f32x2_t v={lo,hi};bf16x2_t b=__builtin_convertvector(v,bf16x2_t);return __builtin_bit_cast(unsigned,b);}
#define WAIT_BAR(N) asm volatile("s_waitcnt vmcnt(" #N ") lgkmcnt(0)\n\ts_barrier":::"memory")

__device__ __forceinline__ void qkt(f32x16&p0,f32x16&p1,const char*Kslot,const bf16x8*qr,int r32,int hi){
  const char*kb=Kslot+hi*1024+r32*16;
  #pragma unroll
  for(int d0=0;d0<4;++d0){
    const bf16x8 b0=*reinterpret_cast<const bf16x8*>(kb+d0*2048);
    const bf16x8 b1=*reinterpret_cast<const bf16x8*>(kb+d0*2048+512);
    {p0=__builtin_amdgcn_mfma_f32_32x32x16_bf16(b0,qr[d0],p0,0,0,0);p1=__builtin_amdgcn_mfma_f32_32x32x16_bf16(b1,qr[d0],p1,0,0,0);}}
}
typedef __attribute__((address_space(3))) const char* lds_cptr;
typedef short v4i16_t __attribute__((ext_vector_type(4)));
__device__ __forceinline__ void kload8(bf16x8*kf,lds_cptr kp){
  kf[0]=*(const __attribute__((address_space(3))) bf16x8*)(kp);      kf[1]=*(const __attribute__((address_space(3))) bf16x8*)(kp+512);
  kf[2]=*(const __attribute__((address_space(3))) bf16x8*)(kp+2048); kf[3]=*(const __attribute__((address_space(3))) bf16x8*)(kp+2560);
  kf[4]=*(const __attribute__((address_space(3))) bf16x8*)(kp+4096); kf[5]=*(const __attribute__((address_space(3))) bf16x8*)(kp+4608);
  kf[6]=*(const __attribute__((address_space(3))) bf16x8*)(kp+6144); kf[7]=*(const __attribute__((address_space(3))) bf16x8*)(kp+6656);
}
__device__ __forceinline__ void kload2(bf16x8*kf,lds_cptr kp,int j){ kf[2*j]=*(const __attribute__((address_space(3))) bf16x8*)(kp+j*2048); kf[2*j+1]=*(const __attribute__((address_space(3))) bf16x8*)(kp+j*2048+512); }
__device__ __forceinline__ s16x4 vtr(lds_cptr p){ return __builtin_bit_cast(s16x4,__builtin_amdgcn_ds_read_tr16_b64_v4i16((__attribute__((address_space(3))) v4i16_t*)p)); }
__device__ __forceinline__ float rowmax(const f32x16&p0,const f32x16&p1){
  float a=max3f(p0[0],p0[1],p1[0]),b=max3f(p0[2],p0[3],p1[1]);a=max3f(a,p1[2],p1[3]);
  #pragma unroll
  for(int r=4;r<16;r+=4){a=max3f(a,p0[r],p0[r+1]);b=max3f(b,p0[r+2],p0[r+3]);a=max3f(a,p1[r],p1[r+1]);b=max3f(b,p1[r+2],p1[r+3]);}
  const float m=max2f(a,b);
  auto rr=__builtin_amdgcn_permlane32_swap(__float_as_uint(m),__float_as_uint(m),false,false);
  return max2f(__uint_as_float(rr[0]),__uint_as_float(rr[1]));
}
__device__ __forceinline__ void pv(f32x16*o,int vb,bf16x8 pa0,bf16x8 pa1,bf16x8 pa2,bf16x8 pa3){
  #pragma unroll
  for(int d0=0;d0<4;++d0){s16x4 lo[4],hi[4];
    #pragma unroll
    for(int ks=0;ks<4;++ks){
      asm volatile("ds_read_b64_tr_b16 %0,%1 offset:%c2":"=&v"(lo[ks]):"v"(vb),"i"(d0*4096+ks*1024):"memory");
      asm volatile("ds_read_b64_tr_b16 %0,%1 offset:%c2":"=&v"(hi[ks]):"v"(vb),"i"(d0*4096+ks*1024+512):"memory");}
    asm volatile("s_waitcnt lgkmcnt(0)":::"memory");SBAR();
    #define PK(k) (bf16x8){lo[k][0],lo[k][1],lo[k][2],lo[k][3],hi[k][0],hi[k][1],hi[k][2],hi[k][3]}
    o[d0]=__builtin_amdgcn_mfma_f32_32x32x16_bf16(pa0,PK(0),o[d0],0,0,0);
    o[d0]=__builtin_amdgcn_mfma_f32_32x32x16_bf16(pa1,PK(1),o[d0],0,0,0);
    o[d0]=__builtin_amdgcn_mfma_f32_32x32x16_bf16(pa2,PK(2),o[d0],0,0,0);
    o[d0]=__builtin_amdgcn_mfma_f32_32x32x16_bf16(pa3,PK(3),o[d0],0,0,0);
    #undef PK
  }
}

#ifndef ATTN_STORE16
#define ATTN_STORE16(p,v) (*(u32x4*)(p)=(v))
#endif
template<int THRL> __device__ __forceinline__ void attn_unit(int b,int qb,int T0,const bf16*Q,const bf16*__restrict__ K,const bf16*__restrict__ V,float*Dg,float cs,float lam,char*shm){
  int tid=threadIdx.x; asm volatile("":"+v"(tid)); const int lane=tid&63,r32=lane&31,hi=lane>>5; const int wid=__builtin_amdgcn_readfirstlane(tid>>6);
  const long rowbase=(long)b*SEQ; const int q0=qb*QB;
  const bf16*Qw=Q+(rowbase+q0+wid*QBLK)*DM;
  const bf16*Kh=K+(rowbase+(long)T0*KVBLK)*DM,*Vh=V+(rowbase+(long)T0*KVBLK)*DM;
  const unsigned lds0=(unsigned)(uintptr_t)shm;
  float*wsf=(float*)(shm+LDS_WS)+wid*64;
  const bf16*ksrc=Kh+(long)lane*DM+wid*8;
  const bf16*vsrc=Vh+(long)(16*(wid&3)+(lane>>2))*DM+(wid>>2)*32+(lane&3)*8;
  const unsigned kdst=lds0+LDS_K+wid*1024, vdst=lds0+LDS_V+wid*1024;
  #define DMA_K(t,slot) glds16(ksrc+(long)(t)*KVBLK*DM,(unsigned)__builtin_amdgcn_readfirstlane(kdst+(slot)))
  #define DMA_V(t,slot) do{ glds16(vsrc+(long)(t)*KVBLK*DM,(unsigned)__builtin_amdgcn_readfirstlane(vdst+2*(slot))); glds16(vsrc+(long)(t)*KVBLK*DM+64,(unsigned)__builtin_amdgcn_readfirstlane(vdst+2*(slot)+8192)); }while(0)
  const int vb0=(int)(lds0+LDS_V)+((lane>>4)&1)*32+(lane&3)*8+(4*hi+((lane&15)>>2))*64;
  const char*Kbase=shm+LDS_K; bf16x8 kf[8];
  const lds_cptr shm3=(lds_cptr)shm; const lds_cptr kp0=shm3+LDS_K+hi*1024+r32*16; const lds_cptr vp0=shm3+LDS_V+((lane>>4)&1)*32+(lane&3)*8+(4*hi+((lane&15)>>2))*64;
  const int NT=(q0+QB)/KVBLK-T0;
  DMA_K(0,0);DMA_V(0,0);DMA_K(1,SLOTB);
  bf16x8 qr[4];
  #pragma unroll
  for(int d0=0;d0<4;++d0)qr[d0]=*reinterpret_cast<const bf16x8*>(&Qw[(long)r32*DM+d0*16+hi*8]);
  float mhat=0.f,l_reg=0.f;f32x16 o[4];o[0]=f32x16{};o[1]=f32x16{};o[2]=f32x16{};o[3]=f32x16{};const float cs32=cs*32.f; const float kb0=cs*(float)(4*hi-(q0+QB)+KVBLK*T0);
  #define BIN0(C0) do{ _Pragma("unroll") for(int r=0;r<16;++r)C0[r]=__builtin_fmaf(cs,(float)((r&3)+8*(r>>2)),sc_); }while(0)
  #define BIN1(C1) do{ _Pragma("unroll") for(int r=0;r<16;++r)C1[r]=__builtin_fmaf(cs,(float)((r&3)+8*(r>>2)),sc_+cs32); }while(0)
  const int qrel=wid*QBLK+r32;
  #define CMASK(P0,P1,t) do{int jb_=(t)-(NT-4); if(jb_>=0)cmask(P0,P1,jb_,qrel,hi);}while(0)
  bool resc=false;
  #define START(P0,P1) do{ const float rm=rowmax(P0,P1); resc=false; \
    { const float dl=rm; mhat=fadd_s(mhat,dl); \
      _Pragma("unroll") for(int r=0;r<16;++r){P0[r]=fsub_s(P0[r],dl);P1[r]=fsub_s(P1[r],dl);} \
      } \
    _Pragma("unroll") for(int r=0;r<16;++r)P0[r]=__builtin_amdgcn_exp2f(P0[r]); }while(0)
  #define RESC() do{ if(resc){ asm volatile("s_waitcnt lgkmcnt(0)":::"memory"); \
      _Pragma("unroll") for(int d_=0;d_<4;++d_) _Pragma("unroll") for(int r=0;r<16;++r)o[d_][r]*=wsf[crow(r,hi)]; } }while(0)
  f32x16 pA0,pA1,pB0,pB1;
  int sl_prev=0,sl_cur=0,sl_next=SLOTB;
  #define ROT() do{sl_prev=sl_cur;sl_cur=sl_next;sl_next=(sl_next==(NSLOT-1)*SLOTB)?0:sl_next+SLOTB;}while(0)
  DMA_K(2,2*SLOTB);
  WAIT_BAR(4);
  SBAR(); {float sc_=kb0-mhat; asm volatile("":"+v"(sc_)); BIN0(pA0); BIN1(pA1);} SBAR(); qkt(pA0,pA1,Kbase,qr,r32,hi);asm volatile("s_nop 15\n\ts_nop 7":"+v"(pA0),"+v"(pA1));CMASK(pA0,pA1,0);
  START(pA0,pA1);
  _Pragma("unroll") for(int r=0;r<16;++r)pA1[r]=__builtin_amdgcn_exp2f(pA1[r]);
  WAIT_BAR(0);
  DMA_K(3,0);DMA_V(1,SLOTB);
  ROT();
  kload8(kf,kp0+sl_cur);
  WAIT_BAR(3);
  s16x4 vlo[8],vhi[8]; u32x4 pw0,pw1,pw2,pw3;
  #define PKW(P,B) cvtpk_s(P[B],P[B+1])
  #define PAF(k) __builtin_bit_cast(bf16x8,pw##k)
  #define VFR(i) (bf16x8){vlo[i][0],vlo[i][1],vlo[i][2],vlo[i][3],vhi[i][0],vhi[i][1],vhi[i][2],vhi[i][3]}
  #define PIN(x) asm volatile("":"+v"(x))
  #define MX3(a,b,c) __builtin_fmaxf(__builtin_fmaxf((a),(b)),(c))
  #define GAPA(MF,A0,A1,A2,A3,W0,W1,PW) do{ MF; sacc+=A0; sacc+=A1; sacc+=A2; sacc+=A3; PIN(sacc); W0; W1; PIN(PW); SBAR(); }while(0)
  #define EX(v) __builtin_amdgcn_exp2f(v)
  #define GAPB(MF,X,B) do{ MF; X[B]=EX(X[B]); X[B+1]=EX(X[B+1]); X[B+2]=EX(X[B+2]); X[B+3]=EX(X[B+3]); PIN(X); SBAR(); }while(0)
  #define VRD(i) do{ vlo[i]=vtr(vp_+(((i)>>2)*4096+((i)&3)*1024)); vhi[i]=vtr(vp_+(((i)>>2)*4096+((i)&3)*1024+512)); }while(0)
  #define GAPB2(MF,X,B) do{ MF; X[B]=EX(X[B]); X[B+1]=EX(X[B+1]); PIN(X); SBAR(); }while(0)
  #define VRD2(i) do{ vlo[i]=vtr(vp_+((2+((i)>>2))*4096+((i)&3)*1024)); vhi[i]=vtr(vp_+((2+((i)>>2))*4096+((i)&3)*1024+512)); SBAR(); }while(0)
  #define KRD(G,j) do{ if(G){ kload2(kf,kp0+sl_next,j); SBAR(); } }while(0)
  #define STEP(C0,C1,P0,P1,t,GK,GV,GL) do{ SBAR(); const float sc_=(kb0+cs*(float)(64*(t)))-mhat; BIN0(C0); SBAR(); \
    const lds_cptr vp_=vp0+2*sl_prev; \
    VRD(0); SBAR(); float sacc=(P0[0]+P0[1]); \
    GAPA(C0=__builtin_amdgcn_mfma_f32_32x32x16_bf16(kf[0],qr[0],C0,0,0,0), P0[2],P0[3],P0[4],P0[5],     pw0[0]=PKW(P0,0), pw0[1]=PKW(P0,2), pw0); \
    VRD(4); SBAR(); BIN1(C1); SBAR(); GAPA(C1=__builtin_amdgcn_mfma_f32_32x32x16_bf16(kf[1],qr[0],C1,0,0,0), P0[6],P0[7],P0[8],P0[9],     pw0[2]=PKW(P0,4), pw0[3]=PKW(P0,6), pw0); \
    VRD(1); SBAR(); GAPA(C0=__builtin_amdgcn_mfma_f32_32x32x16_bf16(kf[2],qr[1],C0,0,0,0),   P0[10],P0[11],P0[12],P0[13], pw1[0]=PKW(P0,8), pw1[1]=PKW(P0,10), pw1); \
    VRD(5); SBAR(); GAPA(C1=__builtin_amdgcn_mfma_f32_32x32x16_bf16(kf[3],qr[1],C1,0,0,0),   P0[14],P0[15],P1[0],P1[1],   pw1[2]=PKW(P0,12),pw1[3]=PKW(P0,14), pw1); \
    VRD(2); SBAR(); GAPA(C0=__builtin_amdgcn_mfma_f32_32x32x16_bf16(kf[4],qr[2],C0,0,0,0),   P1[2],P1[3],P1[4],P1[5],     pw2[0]=PKW(P1,0), pw2[1]=PKW(P1,2), pw2); \
    VRD(6); SBAR(); GAPA(C1=__builtin_amdgcn_mfma_f32_32x32x16_bf16(kf[5],qr[2],C1,0,0,0),   P1[6],P1[7],P1[8],P1[9],     pw2[2]=PKW(P1,4), pw2[3]=PKW(P1,6), pw2); \
    VRD(3); SBAR(); GAPA(C0=__builtin_amdgcn_mfma_f32_32x32x16_bf16(kf[6],qr[3],C0,0,0,0),   P1[10],P1[11],P1[12],P1[13], pw3[0]=PKW(P1,8), pw3[1]=PKW(P1,10), pw3); \
    VRD(7); SBAR(); GAPA(C1=__builtin_amdgcn_mfma_f32_32x32x16_bf16(kf[7],qr[3],C1,0,0,0),   P1[14],P1[15],0.f,0.f,       pw3[2]=PKW(P1,12),pw3[3]=PKW(P1,14), pw3); \
    l_reg+=sacc; \
    if(GK){DMA_K((t)+3,sl_cur);} if(GV){DMA_V((t)+1,sl_next);} \
    CMASK(C0,C1,t); \
    { float a=MX3(C0[0],C0[1],C1[0]),b=MX3(C0[2],C0[3],C1[1]); a=MX3(a,C1[2],C1[3]); \
      _Pragma("unroll") for(int r=4;r<16;r+=4){a=MX3(a,C0[r],C0[r+1]);b=MX3(b,C0[r+2],C0[r+3]);a=MX3(a,C1[r],C1[r+1]);b=MX3(b,C1[r+2],C1[r+3]);} \
      float rm=__builtin_fmaxf(a,b); { auto rr=__builtin_amdgcn_permlane32_swap(__float_as_uint(rm),__float_as_uint(rm),false,false); rm=__builtin_fmaxf(__uint_as_float(rr[0]),__uint_as_float(rr[1])); } \
      resc=false; \
      if(__builtin_expect(__any(rm>(float)THRL),0)){ const float dl=__builtin_fmaxf(rm,0.f); mhat+=dl; \
        _Pragma("unroll") for(int r=0;r<16;++r){C0[r]-=dl;C1[r]-=dl;} \
        const float f=__builtin_amdgcn_exp2f(-dl); l_reg*=f; if(hi==0)wsf[r32]=f; resc=true; } } \
    SBAR(); \
    GAPB2(o[0]=__builtin_amdgcn_mfma_f32_32x32x16_bf16(PAF(0),VFR(0),o[0],0,0,0), C0,0); VRD2(0); \
    GAPB2(o[1]=__builtin_amdgcn_mfma_f32_32x32x16_bf16(PAF(0),VFR(4),o[1],0,0,0), C0,2); VRD2(4); \
    GAPB2(o[0]=__builtin_amdgcn_mfma_f32_32x32x16_bf16(PAF(1),VFR(1),o[0],0,0,0), C0,4); VRD2(1); \
    GAPB2(o[1]=__builtin_amdgcn_mfma_f32_32x32x16_bf16(PAF(1),VFR(5),o[1],0,0,0), C0,6); VRD2(5); \
    GAPB2(o[0]=__builtin_amdgcn_mfma_f32_32x32x16_bf16(PAF(2),VFR(2),o[0],0,0,0), C0,8); VRD2(2); \
    GAPB2(o[1]=__builtin_amdgcn_mfma_f32_32x32x16_bf16(PAF(2),VFR(6),o[1],0,0,0), C0,10); VRD2(6); \
    GAPB2(o[0]=__builtin_amdgcn_mfma_f32_32x32x16_bf16(PAF(3),VFR(3),o[0],0,0,0), C0,12); VRD2(3); \
    GAPB2(o[1]=__builtin_amdgcn_mfma_f32_32x32x16_bf16(PAF(3),VFR(7),o[1],0,0,0), C0,14); VRD2(7); \
    KRD(GL,0); GAPB2(o[2]=__builtin_amdgcn_mfma_f32_32x32x16_bf16(PAF(0),VFR(0),o[2],0,0,0), C1,0); \
    KRD(GL,1); GAPB2(o[3]=__builtin_amdgcn_mfma_f32_32x32x16_bf16(PAF(0),VFR(4),o[3],0,0,0), C1,2); \
    KRD(GL,2); GAPB2(o[2]=__builtin_amdgcn_mfma_f32_32x32x16_bf16(PAF(1),VFR(1),o[2],0,0,0), C1,4); \
    KRD(GL,3); GAPB2(o[3]=__builtin_amdgcn_mfma_f32_32x32x16_bf16(PAF(1),VFR(5),o[3],0,0,0), C1,6); \
    GAPB2(o[2]=__builtin_amdgcn_mfma_f32_32x32x16_bf16(PAF(2),VFR(2),o[2],0,0,0), C1,8); \
    GAPB2(o[3]=__builtin_amdgcn_mfma_f32_32x32x16_bf16(PAF(2),VFR(6),o[3],0,0,0), C1,10); \
    GAPB2(o[2]=__builtin_amdgcn_mfma_f32_32x32x16_bf16(PAF(3),VFR(3),o[2],0,0,0), C1,12); \
    GAPB2(o[3]=__builtin_amdgcn_mfma_f32_32x32x16_bf16(PAF(3),VFR(7),o[3],0,0,0), C1,14); \
    }while(0)
  int t=1;
  #undef CMASK
  #define CMASK(P0,P1,t) do{}while(0)
  for(;t+5<NT;t+=2){
    STEP(pB0,pB1,pA0,pA1,t,true,true,true);     WAIT_BAR(3); RESC(); ROT();
    STEP(pA0,pA1,pB0,pB1,t+1,true,true,true);   WAIT_BAR(3); RESC(); ROT();
  }
  #undef CMASK
  #define CMASK(P0,P1,t) do{int jb_=(t)-(NT-4); if(jb_>=0)cmask(P0,P1,jb_,qrel,hi);}while(0)
  #define ENDW(tt) do{ if((tt)+3<NT){WAIT_BAR(3);} else if((tt)+2<NT){WAIT_BAR(2);} else {WAIT_BAR(0);} }while(0)
  for(;t+1<NT;t+=2){
    STEP(pB0,pB1,pA0,pA1,t,(t+3<NT),(t+1<NT),(t+1<NT));       ENDW(t);   RESC(); ROT();
    STEP(pA0,pA1,pB0,pB1,t+1,(t+4<NT),(t+2<NT),(t+2<NT));     ENDW(t+1); RESC(); ROT();
  }
  STEP(pB0,pB1,pA0,pA1,NT-1,false,false,false); RESC();
  { float sacc=pB0[0]+pB0[1]; _Pragma("unroll") for(int r=2;r<16;++r)sacc+=pB0[r]; _Pragma("unroll") for(int r=0;r<16;++r)sacc+=pB1[r]; l_reg+=sacc;
    pw0=(u32x4){PKW(pB0,0),PKW(pB0,2),PKW(pB0,4),PKW(pB0,6)};pw1=(u32x4){PKW(pB0,8),PKW(pB0,10),PKW(pB0,12),PKW(pB0,14)};pw2=(u32x4){PKW(pB1,0),PKW(pB1,2),PKW(pB1,4),PKW(pB1,6)};pw3=(u32x4){PKW(pB1,8),PKW(pB1,10),PKW(pB1,12),PKW(pB1,14)};
    SBAR(); pv(o,vb0+2*sl_cur,PAF(0),PAF(1),PAF(2),PAF(3)); }
  #undef PKW
  #undef PAF
  #undef VFR
  #undef PIN
  #undef MX3
  #undef GAPA
  #undef GAPB
  #undef GAPB2
  #undef VRD2
  #undef EX
  #undef VRD
  #undef KRD
  #undef STEP
  #undef ENDW
  {auto rr=__builtin_amdgcn_permlane32_swap(__float_as_uint(l_reg),__float_as_uint(l_reg),false,false);l_reg=__uint_as_float(rr[0])+__uint_as_float(rr[1]);}
  if(hi==0)wsf[32+r32]=l_reg;asm volatile("s_waitcnt lgkmcnt(0)":::"memory");
  float rli[16];
  #pragma unroll
  for(int r=0;r<16;++r)rli[r]=__builtin_amdgcn_rcpf(wsf[32+crow(r,hi)]);
  { typedef __attribute__((address_space(1))) float gfloat; gfloat*Dw=(gfloat*)Dg+(rowbase+q0+wid*QBLK+4*hi)*768+r32; asm volatile("":"+v"(Dw));
    #pragma unroll
    for(int r=0;r<16;++r){
      #pragma unroll
      for(int d0=0;d0<4;++d0){ gfloat*p=Dw+((r&3)+8*(r>>2))*768+d0*32; *p=o[d0][r]*rli[r]; } } }
  asm volatile("s_waitcnt lgkmcnt(0)\n\ts_barrier":::"memory");
  #undef DMA_K
  #undef DMA_V
  #undef CMASK
  #undef START
  #undef RESC
  #undef ROT
  #undef BIN0
  #undef BIN1
}
constexpr int ATTN_LDS_BYTES=LDS_BYTES;
#undef SBAR
#undef WAIT_BAR
}

namespace cg = cooperative_groups;
#ifndef MK_ONE_LAUNCH
#define MK_ONE_LAUNCH 1
#endif
constexpr int NWAVES = 8, NTHR = 512;
constexpr int BATCH = 2, SEQ = 8192, DM = 2048, M = BATCH * SEQ, DEPTH = 4, INW = 6400, FFH = 5632, NGU = 2 * FFH;
constexpr int C_RQ = 0, C_RK = 768, C_RV = 1536, C_RG = 2304, C_DQ = 3072, C_DK = 3840, C_DV = 4608, C_SU = 5376, C_SV = 5888;
constexpr float EPS = 1e-6f, LOG2E = 1.4426950408889634f;
constexpr size_t MiB = 1u << 20;
constexpr size_t WS_CTL = 0, CTL_ZERO_BYTES = 65536, WS_SGUW = 1 * MiB, WS_RS = 1 * MiB + 768 * 1024, WS_WIN = 2 * MiB, WS_WOUT = 102 * MiB, WS_WGU = 134 * MiB, WS_WDN = 310 * MiB, WS_XN = 398 * MiB,
                 WS_PROJ = 462 * MiB, WS_HID = 462 * MiB, WS_CAT = 662 * MiB, WS_F32 = 726 * MiB, WS_DIFF = 726 * MiB, WS_KVT = 774 * MiB, WS_RT = 822 * MiB, WS_DIFF1 = 854 * MiB, WS_END = 902 * MiB;
constexpr int CW_QUEUE = 64;
constexpr int CW_BAR = 8192;
constexpr int TS = 136, TILE_B = 128 * TS * 2;
constexpr int RING_BYTES = 4 * TILE_B;
constexpr int MISC_OFF = RING_BYTES, LDS_BYTES = 147456;
static_assert(pg8::STAGE_BYTES <= RING_BYTES && attn_body::LDS_WS + 2048 <= RING_BYTES && MISC_OFF + 256 <= LDS_BYTES, "LDS map");

#define GAS __attribute__((address_space(1)))
#define LAS __attribute__((address_space(3)))
typedef unsigned short bfu;
typedef unsigned v4u __attribute__((ext_vector_type(4)));
typedef unsigned v2u __attribute__((ext_vector_type(2)));
typedef float f32x4 __attribute__((ext_vector_type(4)));
typedef short bf16x8 __attribute__((ext_vector_type(8)));
#define LDS_WAIT() asm volatile("s_waitcnt lgkmcnt(0)" ::: "memory")
__device__ __forceinline__ unsigned f2bf(float f) { unsigned u = __builtin_bit_cast(unsigned, f); return (u + 0x7fffu + ((u >> 16) & 1u)) >> 16; }
__device__ __forceinline__ unsigned pk2(float lo, float hi) { return pg8::cvt_pk_bf16(lo, hi); }
__device__ __forceinline__ float bflo(unsigned w) { return __builtin_bit_cast(float, w << 16); }
__device__ __forceinline__ float bfhi(unsigned w) { return __builtin_bit_cast(float, w & 0xffff0000u); }
__device__ __forceinline__ float wave_sum(float v) {
#pragma unroll
    for (int o = 1; o < 64; o <<= 1) v += __shfl_xor(v, o);
    return v;
}
__device__ __forceinline__ float fexp2(float x) { return __builtin_amdgcn_exp2f(x); }
__device__ __forceinline__ float frcp(float x) { return __builtin_amdgcn_rcpf(x); }
__device__ __forceinline__ float silu_f(float g) { return g * frcp(1.f + fexp2(-LOG2E * g)); }
__device__ __forceinline__ float gelu_tanh(float x) { const float z = 0.7978845608028654f * (x + 0.044715f * x * x * x); return x * frcp(1.f + fexp2(-2.f * LOG2E * z)); }
__device__ __forceinline__ float ret_log2gamma(int h) { return log2f(1.f - exp2f(-5.f - (float)h)); }

#define XB_TMO      128
#define XB_XCNT(j)  (256  + 64 * (j))
#define XB_XSUB(j)  (1280 + 64 * (j))
#define XB_XGEN(j)  (2304 + 64 * (j))
#define XB_TOP      3328
#define XB_TOPGEN   3392
#define XCD_BAR_WORDS 3456
#define XB_SPIN_CAP (1u << 18)

__device__ __forceinline__ unsigned xb_ld(unsigned* p)              { return __hip_atomic_load(p, __ATOMIC_RELAXED, __HIP_MEMORY_SCOPE_AGENT); }
__device__ __forceinline__ unsigned xb_add(unsigned* p, unsigned v) { return __hip_atomic_fetch_add(p, v, __ATOMIC_RELAXED, __HIP_MEMORY_SCOPE_AGENT); }
__device__ __forceinline__ unsigned xb_xcc_id() { return (unsigned)__builtin_amdgcn_s_getreg((3 << 11) | 20) & 0xFu; }
#define XB_SPIN(cond, bar) do { unsigned _sp = 0; while (cond) { __builtin_amdgcn_s_sleep(1); \
    if ((++_sp & 255u) == 0u) { if (xb_ld(&(bar)[XB_TMO])) break; if (_sp > XB_SPIN_CAP) { atomicAdd(&(bar)[XB_TMO], 1u); break; } } } } while (0)

struct XcdBarrier {
    unsigned* bar; unsigned x;
    volatile LAS unsigned* st;
};

__device__ __forceinline__ XcdBarrier xcd_barrier_post(unsigned* bar, volatile LAS unsigned* st) {
    XcdBarrier b; b.bar = bar; b.x = xb_xcc_id(); b.st = st;
    if (threadIdx.x == 0) (void)xb_add(&bar[XB_XCNT(b.x)], 1u);
    return b;
}
__device__ __forceinline__ void xcd_barrier_complete(unsigned* bar, unsigned x, unsigned& nloc, unsigned& nx) {
    const unsigned G = gridDim.x * gridDim.y * gridDim.z;
    unsigned sum, cnt, mine, sp = 0u;
    for (;;) {
        sum = 0u; cnt = 0u; mine = 0u;
#pragma unroll
        for (unsigned j = 0; j < 16; ++j) { const unsigned c = xb_ld(&bar[XB_XCNT(j)]); sum += c; cnt += (c > 0u) ? 1u : 0u; mine = (j == x) ? c : mine; }
        if (sum == G) break;
        __builtin_amdgcn_s_sleep(1);
        if ((++sp & 255u) == 0u) { if (xb_ld(&bar[XB_TMO])) break; if (sp > XB_SPIN_CAP) { atomicAdd(&bar[XB_TMO], 1u); break; } }
    }
    nloc = mine > 0u ? mine : 1u; nx = cnt > 0u ? cnt : 1u;
}

__device__ __forceinline__ void xcd_barrier(const XcdBarrier& b) {
    asm volatile("s_waitcnt vmcnt(0)" ::: "memory");
    __syncthreads();
    if (threadIdx.x == 0) {
        unsigned* bar = b.bar;
        __builtin_amdgcn_s_waitcnt(0);
        unsigned nloc = b.st[0], nx = b.st[1];
        if (nloc == 0u) { xcd_barrier_complete(bar, b.x, nloc, nx); b.st[0] = nloc; b.st[1] = nx; }
        const unsigned old = xb_add(&bar[XB_XSUB(b.x)], 1u);
        const unsigned gen = old / nloc;
        if (old + 1u == (gen + 1u) * nloc) {
            __builtin_amdgcn_fence(__ATOMIC_RELEASE, "agent");
            asm volatile("s_waitcnt vmcnt(0)" ::: "memory");
            const unsigned og = xb_add(&bar[XB_TOP], 1u);
            const unsigned tg = og / nx;
            if (og + 1u == (tg + 1u) * nx) xb_add(&bar[XB_TOPGEN], 1u);
            else XB_SPIN(xb_ld(&bar[XB_TOPGEN]) == tg, bar);
            __builtin_amdgcn_fence(__ATOMIC_ACQUIRE, "agent");
            xb_add(&bar[XB_XGEN(b.x)], 1u);
            asm volatile("s_waitcnt vmcnt(0)" ::: "memory");
        } else {
            XB_SPIN(xb_ld(&bar[XB_XGEN(b.x)]) == gen, bar);
            __builtin_amdgcn_fence(__ATOMIC_ACQUIRE, "agent");
            asm volatile("s_waitcnt vmcnt(0)" ::: "memory");
        }
    }
    __syncthreads();
}

struct Args { const float* in[20]; float* out; unsigned char* ws; int ph_lo, ph_hi; };
__device__ __forceinline__ const float* karg(int k) { int kk = k; asm volatile("" : "+s"(kk)); return ((const float* const __attribute__((address_space(4)))*)__builtin_amdgcn_kernarg_segment_ptr())[kk]; }

__device__ __forceinline__ void p0_transpose_item(const float* W, int K, int N, bfu* WT, int drow0, LAS float* scr, int k0, int n0, int lane, const float* gk) {
#pragma unroll 8
    for (int i = 0; i < 32; ++i) { const int kk = 2 * i + (lane >> 5); scr[kk * 33 + (lane & 31)] = W[(size_t)(k0 + kk) * N + n0 + (lane & 31)]; }
    LDS_WAIT(); asm volatile("" ::: "memory");
    const int c = lane & 7;
    f32x4 ga = (f32x4){1.f, 1.f, 1.f, 1.f}, gb = ga;
    if (gk) { ga = *(const f32x4*)(gk + k0 + 8 * c); gb = *(const f32x4*)(gk + k0 + 8 * c + 4); }
#pragma unroll
    for (int j = 0; j < 4; ++j) { const int n = (lane >> 3) + 8 * j; const LAS float* s = scr + (8 * c) * 33 + n;
        v4u o; o.x = pk2(s[0 * 33] * ga.x, s[1 * 33] * ga.y); o.y = pk2(s[2 * 33] * ga.z, s[3 * 33] * ga.w); o.z = pk2(s[4 * 33] * gb.x, s[5 * 33] * gb.y); o.w = pk2(s[6 * 33] * gb.z, s[7 * 33] * gb.w);
        *(v4u*)(WT + (size_t)(drow0 + n) * K + k0 + 8 * c) = o; }
    LDS_WAIT(); asm volatile("" ::: "memory");
}
__device__ __forceinline__ void xn_rows(const float* x, bfu* XB, float* RS, int gw, int NGW, int lane) {
    for (int m = gw; m < M; m += NGW) {
        const f32x4* xr = (const f32x4*)(x + (size_t)m * DM) + lane; f32x4 v[8]; float s = 0.f;
#pragma unroll
        for (int j = 0; j < 8; ++j) { v[j] = xr[64 * j]; s += (v[j].x * v[j].x + v[j].y * v[j].y) + (v[j].z * v[j].z + v[j].w * v[j].w); }
        const float rstd = 1.f / sqrtf(wave_sum(s) * (1.f / DM) + EPS);
        v2u* o8 = (v2u*)(XB + (size_t)m * DM) + lane;
#pragma unroll
        for (int j = 0; j < 8; ++j) { v2u w; w.x = pk2(v[j].x, v[j].y); w.y = pk2(v[j].z, v[j].w); o8[64 * j] = w; }
        if (lane == 0) RS[m] = rstd;
    }
}
template <bool FINAL, bool DUMMY = false> __device__ __forceinline__ void norm_rows(const bfu* F, bfu* XB, const float* g1, float* RS, float* xout, int gw, int NGW, int lane, bfu* dummy = nullptr) {
    int m = gw; if (m >= M) return;
    v2u fw[8], xw[8];
#pragma unroll
    for (int j = 0; j < 8; ++j) { fw[j] = ((const v2u*)(F + (size_t)m * DM) + lane)[64 * j]; xw[j] = ((const v2u*)(XB + (size_t)m * DM) + lane)[64 * j]; }
    for (; m < M; m += NGW) {
        f32x4 f[8], x[8]; float s = 0.f;
#pragma unroll
        for (int j = 0; j < 8; ++j) { f[j] = (f32x4){bflo(fw[j].x), bfhi(fw[j].x), bflo(fw[j].y), bfhi(fw[j].y)}; x[j] = (f32x4){bflo(xw[j].x), bfhi(xw[j].x), bflo(xw[j].y), bfhi(xw[j].y)}; }
        const int mn = m + NGW;
        if (mn < M) {
#pragma unroll
            for (int j = 0; j < 8; ++j) { fw[j] = ((const v2u*)(F + (size_t)mn * DM) + lane)[64 * j]; xw[j] = ((const v2u*)(XB + (size_t)mn * DM) + lane)[64 * j]; }
        }
#pragma unroll
        for (int j = 0; j < 8; ++j) s += (f[j].x * f[j].x + f[j].y * f[j].y) + (f[j].z * f[j].z + f[j].w * f[j].w);
        const float rstd1 = 1.f / sqrtf(wave_sum(s) * (1.f / DM) + EPS);
        float s2 = 0.f;
#pragma unroll
        for (int j = 0; j < 8; ++j) { const f32x4 gg = ((const f32x4*)g1)[lane + 64 * j]; x[j] = x[j] + f[j] * rstd1 * gg; s2 += (x[j].x * x[j].x + x[j].y * x[j].y) + (x[j].z * x[j].z + x[j].w * x[j].w); }
        if (FINAL) { f32x4* xo = (f32x4*)(xout + (size_t)m * DM) + lane;
#pragma unroll
            for (int j = 0; j < 8; ++j) xo[64 * j] = x[j];
        } else {
            v2u* xr = (v2u*)((DUMMY ? dummy : XB) + (size_t)m * DM) + lane;
#pragma unroll
            for (int j = 0; j < 8; ++j) { v2u w; w.x = pk2(x[j].x, x[j].y); w.y = pk2(x[j].z, x[j].w); xr[64 * j] = w; }
            const float rstd2 = 1.f / sqrtf(wave_sum(s2) * (1.f / DM) + EPS);
            if (lane == 0) (DUMMY ? (float*)dummy + (size_t)M * DM : RS)[m] = rstd2;
        }
    }
}

__device__ __forceinline__ void stage_nat(LAS bfu* dst, const bfu* src, int pitch, int tid) {
#pragma unroll
    for (int i = 0; i < 4; ++i) { const int id = tid + NTHR * i, r = id >> 4, ch = id & 15; const v4u v = *(const v4u*)(src + (size_t)r * pitch + ch * 8); *(LAS v4u*)(dst + r * TS + ch * 8) = v; }
}
template <bool SC> __device__ __forceinline__ void stage_tr(LAS bfu* dst, const bfu* src, int pitch, int tid, float lg) {
#pragma unroll
    for (int i = 0; i < 4; ++i) { const int id = tid + NTHR * i, c = id & 127, ch = id >> 7; const v4u v = *(const v4u*)(src + (size_t)c * pitch + ch * 8);
        const float sc = SC ? fexp2(lg * (float)(127 - c)) : 1.f;
#pragma unroll
        for (int j = 0; j < 4; ++j) { unsigned w = v[j];
            if (SC) w = pk2(bflo(w) * sc, bfhi(w) * sc);
            dst[(ch * 8 + 2 * j) * TS + c] = (bfu)(w & 0xffffu); dst[(ch * 8 + 2 * j + 1) * TS + c] = (bfu)(w >> 16); } }
}
__device__ __forceinline__ void wave_mma(f32x4 (&acc)[8], const LAS bfu* As, const LAS bfu* Bs, int m0, int fr, int fq) {
#pragma unroll
    for (int ks = 0; ks < 4; ++ks) { const bf16x8 a = *(const LAS bf16x8*)(As + (m0 + fr) * TS + ks * 32 + fq * 8);
#pragma unroll
        for (int t = 0; t < 8; ++t) { const bf16x8 b = *(const LAS bf16x8*)(Bs + (t * 16 + fr) * TS + ks * 32 + fq * 8); acc[t] = __builtin_amdgcn_mfma_f32_16x16x32_bf16(b, a, acc[t], 0, 0, 0); } }
}
#define ZERO8(a) do { _Pragma("unroll") for (int t_ = 0; t_ < 8; ++t_) a[t_] = (f32x4){0.f, 0.f, 0.f, 0.f}; } while (0)

#ifndef PG8ALIGN
#define PG8ALIGN true
#endif
#ifndef PG8SP2
#define PG8SP2 true
#endif
#ifndef XSKIP
#define XSKIP 1
#endif
#ifndef XTAIL
#define XTAIL 0
#endif
#ifndef ATT_THRL
#define ATT_THRL 80
#endif
constexpr int Q_SCAN = 768, Q_ATT = Q_SCAN + 96, Q_RET = Q_ATT + 768, Q_SGU = Q_RET + 768, Q_END = Q_SGU + 512;
__device__ __forceinline__ void st_sc1_u2(void* p, unsigned lo, unsigned hi) { __hip_atomic_store((GAS unsigned long long*)p, ((unsigned long long)hi << 32) | (unsigned long long)lo, __ATOMIC_RELAXED, __HIP_MEMORY_SCOPE_AGENT); }
__device__ __forceinline__ void st_sc1_x4(float* p, f32x4 v) { st_sc1_u2(p, __float_as_uint(v[0]), __float_as_uint(v[1])); st_sc1_u2(p + 2, __float_as_uint(v[2]), __float_as_uint(v[3])); }
__device__ __forceinline__ void publish(unsigned* word) {
    asm volatile("s_waitcnt vmcnt(0)" ::: "memory"); __syncthreads();
    if (threadIdx.x == 0) __hip_atomic_fetch_add(word, 1u, __ATOMIC_RELAXED, __HIP_MEMORY_SCOPE_AGENT);
}
__device__ __forceinline__ void publish_release(unsigned* word) {
    asm volatile("s_waitcnt vmcnt(0)" ::: "memory"); __syncthreads();
    if (threadIdx.x == 0) { __builtin_amdgcn_fence(__ATOMIC_RELEASE, "agent"); asm volatile("s_waitcnt vmcnt(0)" ::: "memory"); __hip_atomic_fetch_add(word, 1u, __ATOMIC_RELAXED, __HIP_MEMORY_SCOPE_AGENT); }
}
__device__ __forceinline__ void wait_ge(unsigned* word, unsigned want, unsigned* tmo) {
    if (threadIdx.x == 0) {
        unsigned sp = 0;
        while (__hip_atomic_load(word, __ATOMIC_RELAXED, __HIP_MEMORY_SCOPE_AGENT) < want) {
            __builtin_amdgcn_s_sleep(2);
            if (++sp > (1u << 21)) { __hip_atomic_store(tmo, 1u, __ATOMIC_RELAXED, __HIP_MEMORY_SCOPE_AGENT); break; }
            if ((sp & 1023u) == 0u && __hip_atomic_load(tmo, __ATOMIC_RELAXED, __HIP_MEMORY_SCOPE_AGENT)) break;
        }
        __builtin_amdgcn_fence(__ATOMIC_ACQUIRE, "agent");
        asm volatile("s_waitcnt vmcnt(0)" ::: "memory");
    }
    __syncthreads();
}
__device__ __forceinline__ void qk_norms(LAS unsigned char* lds, const bfu* PROJ, unsigned* nw) {
    int tid = threadIdx.x; asm volatile("" : "+v"(tid)); const int lane = tid & 63, wid = __builtin_amdgcn_readfirstlane(tid >> 6);
    const int gw = blockIdx.x * NWAVES + wid, NGW = gridDim.x * NWAVES;
    float m0[3] = {0.f, 0.f, 0.f}, m1[3] = {0.f, 0.f, 0.f};
    for (int mb = gw; mb < M; mb += 4 * NGW) {
        v4u w[4][3];
#pragma unroll
        for (int r = 0; r < 4; ++r) { const int m = mb + r * NGW; const bfu* rp = PROJ + (size_t)(m < M ? m : mb) * INW + C_DQ + lane * 8;
#pragma unroll
            for (int ld = 0; ld < 3; ++ld) w[r][ld] = *(const v4u*)(rp + ld * 512); }
#pragma unroll
        for (int r = 0; r < 4; ++r) { const int m = mb + r * NGW; if (m >= M) break; float s[3];
#pragma unroll
            for (int ld = 0; ld < 3; ++ld) { float a = 0.f;
#pragma unroll
                for (int j = 0; j < 4; ++j) { const float lo = bflo(w[r][ld][j]), hi = bfhi(w[r][ld][j]); a += lo * lo + hi * hi; }
                a += __shfl_xor(a, 1); a += __shfl_xor(a, 2); a += __shfl_xor(a, 4); s[ld] = a; }
            if (m >= SEQ) { m1[0] = fmaxf(m1[0], s[0]); m1[1] = fmaxf(m1[1], s[1]); m1[2] = fmaxf(m1[2], s[2]); }
            else          { m0[0] = fmaxf(m0[0], s[0]); m0[1] = fmaxf(m0[1], s[1]); m0[2] = fmaxf(m0[2], s[2]); } }
    }
    LAS float* red = (LAS float*)lds;
    if ((lane & 7) == 0) {
#pragma unroll
        for (int ld = 0; ld < 3; ++ld) { red[wid * 48 + ld * 8 + (lane >> 3)] = m0[ld]; red[wid * 48 + 24 + ld * 8 + (lane >> 3)] = m1[ld]; } }
    __syncthreads();
    if (tid < 48) { float v = red[tid];
#pragma unroll
        for (int w = 1; w < 8; ++w) v = fmaxf(v, red[w * 48 + tid]);
        const unsigned old = __hip_atomic_fetch_max(nw + tid, __float_as_uint(v), __ATOMIC_RELAXED, __HIP_MEMORY_SCOPE_AGENT); asm volatile("" :: "v"(old)); }
}
struct AttnOrder { unsigned char u[2][96]; };
constexpr AttnOrder make_attn_order() {
    AttnOrder o{}; const int win[6] = {12, 20, 40, 96, 999, 999}; const int hd[2][3] = {{0, 3, 5}, {1, 2, 4}};
    for (int ty = 0; ty < 2; ++ty) { int cost[96] = {}; int id[96] = {}; int n = 0;
        for (int qb = 31; qb >= 0; --qb) for (int sl = 0; sl < 3; ++sl) { const int w = win[hd[ty][sl]], c = (4 * qb + 4 < w) ? 4 * qb + 4 : w; cost[n] = c; id[n] = (sl << 5) | qb; ++n; }
        for (int i = 1; i < 96; ++i) { const int c = cost[i], v = id[i]; int j = i - 1; while (j >= 0 && cost[j] < c) { cost[j + 1] = cost[j]; id[j + 1] = id[j]; --j; } cost[j + 1] = c; id[j + 1] = v; }
        for (int i = 0; i < 96; ++i) o.u[ty][i] = (unsigned char)id[i]; }
    return o;
}
__device__ const AttnOrder ATTN_ORDER = make_attn_order();
__device__ __forceinline__ void kv_unit(LAS unsigned char* lds, const bfu* PROJ, float* KVT, int u) {
    int tid = threadIdx.x; asm volatile("" : "+v"(tid)); const int lane = tid & 63, wid = __builtin_amdgcn_readfirstlane(tid >> 6); (void)lane; (void)wid;
    const int bh = u >> 6, i = u & 63, b = bh / 6, h = bh % 6; const size_t row0 = (size_t)b * SEQ + (size_t)i * 128; const float lg = ret_log2gamma(h);
    LAS bfu* Vt = (LAS bfu*)lds; LAS bfu* Kt = (LAS bfu*)(lds + TILE_B);
    stage_tr<false>(Vt, PROJ + row0 * INW + C_RV + h * 128, INW, tid, 0.f);
    stage_tr<true>(Kt, PROJ + row0 * INW + C_RK + h * 128, INW, tid, lg);
    __syncthreads();
    const int fr = lane & 15, fq = lane >> 4, m0 = wid * 16; f32x4 acc[8]; ZERO8(acc);
    wave_mma(acc, Vt, Kt, m0, fr, fq);
    float* o = KVT + (size_t)u * 16384 + (m0 + fr) * 128 + 4 * fq;
#pragma unroll
    for (int t = 0; t < 8; ++t) st_sc1_x4(o + 16 * t, acc[t]);
}
__device__ __forceinline__ void scan_unit(const float* KVT, bfu* RT, int s) {
    int tid = threadIdx.x; asm volatile("" : "+v"(tid)); const int lane = tid & 63, wid = __builtin_amdgcn_readfirstlane(tid >> 6); (void)lane; (void)wid;
    const int bh = s >> 3, part = s & 7, h = bh % 6; const float G = exp2f(ret_log2gamma(h) * 128.f);
    const size_t e = (size_t)bh * 64 * 16384 + part * 2048 + tid * 4; f32x4 st = (f32x4){0.f, 0.f, 0.f, 0.f};
#pragma unroll 8
    for (int i = 0; i < 64; ++i) { const f32x4 cur = *(const f32x4*)(KVT + e + (size_t)i * 16384); st_sc1_u2(RT + e + (size_t)i * 16384, pk2(st[0], st[1]), pk2(st[2], st[3])); st = cur + st * G; }
}
__device__ __forceinline__ void ret_unit(LAS unsigned char* lds, const bfu* PROJ, const bfu* RT, const float* gn_g, bfu* CAT, int u) {
    int tid = threadIdx.x; asm volatile("" : "+v"(tid)); const int lane = tid & 63, wid = __builtin_amdgcn_readfirstlane(tid >> 6); (void)lane; (void)wid;
    const int bh = u >> 6, i = u & 63, b = bh / 6, h = bh % 6; const size_t row0 = (size_t)b * SEQ + (size_t)i * 128; const float lg = ret_log2gamma(h);
    LAS bfu* Qs = (LAS bfu*)lds; LAS bfu* Ks = (LAS bfu*)(lds + TILE_B); LAS bfu* Vt = (LAS bfu*)(lds + 2 * TILE_B); LAS bfu* Rt = (LAS bfu*)(lds + 3 * TILE_B);
    const bfu* P0 = PROJ + row0 * INW + h * 128;
    stage_nat(Qs, P0 + C_RQ, INW, tid); stage_nat(Ks, P0 + C_RK, INW, tid); stage_tr<false>(Vt, P0 + C_RV, INW, tid, 0.f); stage_nat(Rt, RT + (size_t)u * 16384, 128, tid);
    __syncthreads();
    const int fr = lane & 15, fq = lane >> 4, m0 = wid * 16, c = m0 + fr;
    f32x4 acc[8], cr[8]; ZERO8(acc); ZERO8(cr);
    wave_mma(cr, Qs, Rt, m0, fr, fq);
    wave_mma(acc, Qs, Ks, m0, fr, fq);
    __syncthreads();
#pragma unroll
    for (int t = 0; t < 8; ++t) { float p[4];
#pragma unroll
        for (int j = 0; j < 4; ++j) { const int e = 16 * t + 4 * fq + j; p[j] = (c >= e) ? acc[t][j] * fexp2(lg * (float)(c - e)) : 0.f; }
        v2u w; w.x = pk2(p[0], p[1]); w.y = pk2(p[2], p[3]); *(LAS v2u*)(Ks + c * TS + 16 * t + 4 * fq) = w; }
    LDS_WAIT(); asm volatile("" ::: "memory");
    ZERO8(acc);
    wave_mma(acc, Ks, Vt, m0, fr, fq);
    const float xi = fexp2(lg * (float)(c + 1)); float s = 0.f;
#pragma unroll
    for (int t = 0; t < 8; ++t) { acc[t] = acc[t] + cr[t] * xi; s += (acc[t][0] + acc[t][1]) + (acc[t][2] + acc[t][3]); }
    s += __shfl_xor(s, 16); s += __shfl_xor(s, 32); const float mu = s * (1.f / 128.f); float q = 0.f;
#pragma unroll
    for (int t = 0; t < 8; ++t) { acc[t] = acc[t] - mu; q += (acc[t][0] * acc[t][0] + acc[t][1] * acc[t][1]) + (acc[t][2] * acc[t][2] + acc[t][3] * acc[t][3]); }
    q += __shfl_xor(q, 16); q += __shfl_xor(q, 32); const float rstd = 1.f / sqrtf(q * (1.f / 128.f) + EPS);
    const bfu* gp = P0 + (size_t)c * INW + C_RG + 4 * fq; bfu* op = CAT + (row0 + c) * DM + h * 128 + 4 * fq; const float* gg = gn_g + h * 128 + 4 * fq;
#pragma unroll
    for (int t = 0; t < 8; ++t) { const v2u gw = *(const v2u*)(gp + 16 * t); const f32x4 g4 = *(const f32x4*)(gg + 16 * t);
        const float o0 = silu_f(bflo(gw.x)) * acc[t][0] * rstd * g4.x, o1 = silu_f(bfhi(gw.x)) * acc[t][1] * rstd * g4.y, o2 = silu_f(bflo(gw.y)) * acc[t][2] * rstd * g4.z, o3 = silu_f(bfhi(gw.y)) * acc[t][3] * rstd * g4.w;
        v2u w; w.x = pk2(o0, o1); w.y = pk2(o2, o3); *(v2u*)(op + 16 * t) = w; }
    __syncthreads();
}
__device__ __forceinline__ void sgu_unit(LAS unsigned char* lds, const bfu* PROJ, const bfu* SW  , const float* ln_g, const float* ln_b, const float* sb, bfu* CAT, int s) {
    int tid = threadIdx.x; asm volatile("" : "+v"(tid)); const int lane = tid & 63, wid = __builtin_amdgcn_readfirstlane(tid >> 6); (void)lane; (void)wid;
    const int chunk = s >> 2, g = s & 3; const size_t row0 = (size_t)chunk * 128;
    LAS bfu* Ws = (LAS bfu*)lds; LAS bfu* Vt = (LAS bfu*)(lds + TILE_B); LAS float* red = (LAS float*)(lds + 2 * TILE_B);
    stage_nat(Ws, SW + (size_t)g * 16384, 128, tid);
    const int sr = tid & 127, qd = tid >> 7;
    const bfu* vp = PROJ + (row0 + sr) * INW + C_SV + g * 128 + qd * 32; float v[32]; float a = 0.f, a2 = 0.f;
#pragma unroll
    for (int k = 0; k < 4; ++k) { const v4u w = *(const v4u*)(vp + 8 * k);
#pragma unroll
        for (int j = 0; j < 4; ++j) { const float x0 = gelu_tanh(bflo(w[j])), x1 = gelu_tanh(bfhi(w[j])); v[8 * k + 2 * j] = x0; v[8 * k + 2 * j + 1] = x1; a += x0 + x1; a2 += x0 * x0 + x1 * x1; } }
    red[qd * 128 + sr] = a; red[512 + qd * 128 + sr] = a2;
    __syncthreads();
    { const float sm = (red[sr] + red[128 + sr]) + (red[256 + sr] + red[384 + sr]), sq = (red[512 + sr] + red[640 + sr]) + (red[768 + sr] + red[896 + sr]);
      const float mu = sm * (1.f / 128.f), var = fmaxf(sq * (1.f / 128.f) - mu * mu, 0.f), rstd = 1.f / sqrtf(var + EPS);
      const float* lg_ = ln_g + g * 128 + qd * 32; const float* lb_ = ln_b + g * 128 + qd * 32;
#pragma unroll
      for (int k = 0; k < 32; ++k) Vt[(qd * 32 + k) * TS + sr] = (bfu)f2bf((v[k] - mu) * rstd * lg_[k] + lb_[k]); }
    __syncthreads();
    const int fr = lane & 15, fq = lane >> 4, m0 = wid * 16, t_ = m0 + fr; f32x4 acc[8]; ZERO8(acc);
    wave_mma(acc, Ws, Vt, m0, fr, fq);
    const float bias = sb[g * 128 + t_];
    const bfu* up = PROJ + (row0 + t_) * INW + C_SU + g * 128 + 4 * fq; bfu* op = CAT + (row0 + t_) * DM + 1536 + g * 128 + 4 * fq;
#pragma unroll
    for (int t = 0; t < 8; ++t) { const v2u uw = *(const v2u*)(up + 16 * t);
        v2u w; w.x = pk2(gelu_tanh(bflo(uw.x)) * (acc[t][0] + bias), gelu_tanh(bfhi(uw.x)) * (acc[t][1] + bias)); w.y = pk2(gelu_tanh(bflo(uw.y)) * (acc[t][2] + bias), gelu_tanh(bfhi(uw.y)) * (acc[t][3] + bias));
        *(v2u*)(op + 16 * t) = w; }
    __syncthreads();
}
__device__ __forceinline__ void diff_final(const float* D0, const float* D1, float lam, const float* sg, float omli, bfu* CAT, int gw, int NGW, int lane) {
    const int half = lane >> 5, l32 = lane & 31;
    for (int it = gw * 2 + half; it < M * 6; it += NGW * 2) { const int row = it / 6, h = it - row * 6;
        const f32x4 v = *(const f32x4*)(D0 + (size_t)row * 768 + h * 128 + l32 * 4) - *(const f32x4*)(D1 + (size_t)row * 768 + h * 128 + l32 * 4) * lam; float s = (v.x * v.x + v.y * v.y) + (v.z * v.z + v.w * v.w);
#pragma unroll
        for (int o = 1; o < 32; o <<= 1) s += __shfl_xor(s, o);
        const float r = omli / sqrtf(s * (1.f / 128.f) + EPS); const f32x4 g4 = *(const f32x4*)(sg + h * 128 + l32 * 4);
        v2u w; w.x = pk2(v.x * r * g4.x, v.y * r * g4.y); w.y = pk2(v.z * r * g4.z, v.w * r * g4.w); *(v2u*)(CAT + (size_t)row * DM + 768 + h * 128 + l32 * 4) = w; }
}

__global__ void __launch_bounds__(NTHR, 2) fwd(Args args) {
    extern __shared__ __attribute__((aligned(16))) unsigned char lds_raw[];
    LAS unsigned char* lds = (LAS unsigned char*)lds_raw;
    volatile LAS int* MISC = (volatile LAS int*)(lds + MISC_OFF);
    const int G = gridDim.x, NGW = G * NWAVES;
#define PIN_TID() int tid = threadIdx.x; asm volatile("" : "+v"(tid)); const int lane = tid & 63, wid = __builtin_amdgcn_readfirstlane(tid >> 6), gw = blockIdx.x * NWAVES + wid; (void)lane; (void)gw
#define WSB ((unsigned char*)karg(21))
#define ctl ((unsigned*)(WSB + WS_CTL))
#define SGUW ((bfu*)(WSB + WS_SGUW))
#define WIN ((bfu*)(WSB + WS_WIN))
#define WOUT ((bfu*)(WSB + WS_WOUT))
#define WGU ((bfu*)(WSB + WS_WGU))
#define WDN ((bfu*)(WSB + WS_WDN))
#define XN ((bfu*)(WSB + WS_XN))
#define PROJ ((bfu*)(WSB + WS_PROJ))
#define HID ((bfu*)(WSB + WS_HID))
#define CAT ((bfu*)(WSB + WS_CAT))
#define F32 ((bfu*)(WSB + WS_F32))
#define DIFF ((float*)(WSB + WS_DIFF))
#define DIFF1 ((float*)(WSB + WS_DIFF1))
#define KVT ((float*)(WSB + WS_KVT))
#define RT ((bfu*)(WSB + WS_RT))
#define RS ((float*)(WSB + WS_RS))
#define x_in karg(0)
#define out ((float*)karg(20))
    const int lo = args.ph_lo, hi = args.ph_hi;
    if (threadIdx.x < 64) MISC[threadIdx.x] = 0;
    __syncthreads();
    XcdBarrier bar = xcd_barrier_post(ctl + CW_BAR, (volatile LAS unsigned*)(MISC + 8));
    int ph = 0;
    if (lo < 0) cg::this_grid().sync();
#ifndef X_MASK
#define X_MASK 1023
#endif
#define XEN(k) (((X_MASK) >> (k)) & 1)
#ifndef X_REPMASK
#define X_REPMASK 0
#endif
#define XREP(k) (1 + (((X_REPMASK) >> (k)) & 1))
#define IN_PH() (lo <= ph && ph < hi)
#define SEAM() do { if (lo <= ph && ph + 1 < hi) { xcd_barrier(bar); if (XREP(10) > 1) xcd_barrier(bar); } ++ph; } while (0)

    if (XEN(0) && IN_PH()) for (int rep = 0; rep < XREP(0); ++rep) { PIN_TID();
        LAS float* scr = (LAS float*)(lds + wid * 16384);
        constexpr int I_IN = 32 * 200, I_OUT = 32 * 64, I_G = 32 * 176, I_D = 88 * 64, I_L = I_IN + I_OUT + 2 * I_G + I_D;
        for (int it = gw; it < DEPTH * I_L; it += NGW) {
            const int l = it / I_L; int r = it - l * I_L;
            if (r < I_IN) { const int kb = r / 200, nb = r % 200; p0_transpose_item(karg(2) + (size_t)l * DM * INW, DM, INW, WIN + (size_t)l * INW * DM, 32 * nb, scr, 64 * kb, 32 * nb, lane, karg(1) + l * DM); continue; } r -= I_IN;
            if (r < I_OUT) { const int kb = r / 64, nb = r % 64; p0_transpose_item(karg(13) + (size_t)l * DM * DM, DM, DM, WOUT + (size_t)l * DM * DM, 32 * nb, scr, 64 * kb, 32 * nb, lane, nullptr); continue; } r -= I_OUT;
            if (r < I_G) { const int kb = r / 176, nb = r % 176, n0 = 32 * nb; p0_transpose_item(karg(16) + (size_t)l * DM * FFH, DM, FFH, WGU + (size_t)l * NGU * DM, (n0 >> 7) * 256 + (n0 & 127), scr, 64 * kb, n0, lane, karg(15) + l * DM); continue; } r -= I_G;
            if (r < I_G) { const int kb = r / 176, nb = r % 176, n0 = 32 * nb; p0_transpose_item(karg(17) + (size_t)l * DM * FFH, DM, FFH, WGU + (size_t)l * NGU * DM, (n0 >> 7) * 256 + 128 + (n0 & 127), scr, 64 * kb, n0, lane, karg(15) + l * DM); continue; } r -= I_G;
            { const int kb = r / 64, nb = r % 64; p0_transpose_item(karg(18) + (size_t)l * FFH * DM, FFH, DM, WDN + (size_t)l * DM * FFH, 32 * nb, scr, 64 * kb, 32 * nb, lane, nullptr); }
        }
        for (int e = blockIdx.x * NTHR + tid; e < DEPTH * 4 * 128 * 128; e += G * NTHR) { const int s_ = e & 127, t_ = (e >> 7) & 127; SGUW[e] = (bfu)f2bf(s_ <= t_ ? karg(11)[e] : 0.f); }
        xn_rows(x_in, XN, RS, gw, NGW, lane);
        __syncthreads();
    }
    SEAM();

    for (int l = 0; l < DEPTH; ++l) {
#define lambda_init (0.8f - 0.6f * expf(-0.3f * (float)l))
        if (XEN(1) && IN_PH()) for (int rep = 0; rep < XREP(1); ++rep) { PIN_TID();
            pg8::Gemm g{XN, WIN + (size_t)l * INW * DM, M, INW, DM}; pg8::StaticOrder S; S.init(M, INW - 256 * XTAIL, G, (int)blockIdx.x);
            pg8::EpiProj E{PROJ, INW, RS};
            pg8::gemm_phase<pg8::EpiProj, pg8::StaticOrder, PG8ALIGN, PG8SP2>(lds, g, S, E);
        }
        SEAM();
        if (XEN(3) && IN_PH()) for (int rep = 0; rep < XREP(3); ++rep) { PIN_TID();
            unsigned* cw = ctl + CW_QUEUE + 1024 * l + 32 * rep;
#define PULL_ISSUE(hd) ((tid == 0) ? (int)__hip_atomic_fetch_add((hd), 1u, __ATOMIC_RELAXED, __HIP_MEMORY_SCOPE_AGENT) : 0)
#define BCAST(v) ({ if (tid == 0) MISC[0] = (v); __syncthreads(); const int u__ = __builtin_amdgcn_readfirstlane(MISC[0]); __syncthreads(); u__; })
            qk_norms(lds, PROJ, cw + 64 * 15); publish(cw + 64 * 14);
            { int nx = PULL_ISSUE(cw);
              for (;;) {
                const int u = BCAST(nx);
                if (u >= 768 + 96) break;
                nx = PULL_ISSUE(cw);
                if (u < 768) { kv_unit(lds, PROJ, KVT, u); publish(cw + 64 + (u >> 6)); }
                else { const int s_ = u - 768; wait_ge(cw + 64 + (s_ >> 3), 64u, cw + 192); scan_unit(KVT, RT, s_); publish(cw + 128 + (s_ >> 3)); }
              } }
#ifndef X_NO_ATTN
            wait_ge(cw + 64 * 14, (unsigned)G, cw + 192);
            { const int myx = (int)(xb_xcc_id() & 7u);
              unsigned stealmask = 1u;
              for (int k = 0; k < 8; ++k) { if (!((stealmask >> k) & 1u)) continue;
                const int x = (myx + k) & 7; unsigned* hd = cw + 64 * (4 + x);
                for (;;) {
                    const int j = BCAST(PULL_ISSUE(hd));
                    if (j >= 96) break;
                    const int ou_ = __builtin_amdgcn_readfirstlane((int)ATTN_ORDER.u[x < 4 ? 0 : 1][j]), qb = ou_ & 31, sl_ = ou_ >> 5, b = (x & 3) >> 1, mp = x & 1, h = (x < 4) ? (sl_ == 0 ? 0 : (sl_ == 1 ? 3 : 5)) : (sl_ == 0 ? 1 : (sl_ == 1 ? 2 : 4));
                    const float cs = __builtin_bit_cast(float, __builtin_amdgcn_readfirstlane(__builtin_bit_cast(int, exp2f(-8.f * (float)(h + 1) / 6.f) * LOG2E)));
                    const attn_body::bf16* Pj = (const attn_body::bf16*)PROJ; float* Dg = (mp ? DIFF1 : DIFF) + h * 128;
                    int t0 = 0;
                    { const unsigned* nwp = cw + 64 * 15 + b * 24 + h * 2 + mp;
                      const float nq = __uint_as_float(__hip_atomic_load(nwp, __ATOMIC_RELAXED, __HIP_MEMORY_SCOPE_AGENT)), nk = __uint_as_float(__hip_atomic_load(nwp + 12, __ATOMIC_RELAXED, __HIP_MEMORY_SCOPE_AGENT));
                      const float Bq = sqrtf(nq * nk) * 1.01f + 0.01f, lim = 256.f * (float)qb - 63.f - (2.f * Bq + 160.f) / cs;
                      if (lim >= 0.f) { const int tmax = (int)floorf(lim * (1.f / 64.f)); t0 = (tmax + 1) & ~1; if (t0 > 4 * qb) t0 = 4 * qb; }
                      t0 = __builtin_amdgcn_readfirstlane(t0); }
                    attn_body::attn_unit<ATT_THRL>(b, qb, XSKIP ? t0 : 0, Pj + C_DQ + h * 128 + 64 * mp, Pj + C_DK + h * 128 + 64 * mp, Pj + C_DV + h * 128, Dg, cs, 0.f, (char*)lds_raw);
                }
                if (k == 0) {
                    int av = 0;
                    if (tid < 8) av = (tid > 0 && __hip_atomic_load(cw + 64 * (4 + ((myx + tid) & 7)), __ATOMIC_RELAXED, __HIP_MEMORY_SCOPE_AGENT) < 96u) ? (1 << tid) : 0;
                    if (tid < 8) { av |= __shfl_xor(av, 1); av |= __shfl_xor(av, 2); av |= __shfl_xor(av, 4); }
                    stealmask = (unsigned)BCAST(av);
                }
              } }
#endif
            { int nx = PULL_ISSUE(cw + 64 * 12);
              for (;;) {
                const int u = BCAST(nx);
                if (u >= 768 + 512) break;
                nx = PULL_ISSUE(cw + 64 * 12);
                if (u < 768) { wait_ge(cw + 128 + (u >> 6), 8u, cw + 192); ret_unit(lds, PROJ, RT, karg(3) + l * 768, CAT, u); }
                else sgu_unit(lds, PROJ, SGUW + (size_t)l * 65536, karg(9) + l * 512, karg(10) + l * 512, karg(12) + l * 512, CAT, u - 768);
              } }
#undef PULL_ISSUE
#undef BCAST
        }
        SEAM();
        if (XEN(4) && IN_PH()) for (int rep = 0; rep < XREP(4); ++rep) { PIN_TID();
            float lam;
            { const float a = (lane < 64) ? karg(4)[l * 64 + lane] * karg(5)[l * 64 + lane] : 0.f, b_ = karg(6)[l * 64 + lane] * karg(7)[l * 64 + lane];
              lam = expf(wave_sum(a)) - expf(wave_sum(b_)) + lambda_init; lam = __builtin_bit_cast(float, __builtin_amdgcn_readfirstlane(__builtin_bit_cast(int, lam))); }
            diff_final(DIFF, DIFF1, lam, karg(8) + l * 768, 1.f - lambda_init, CAT, gw, NGW, lane);
        }
        SEAM();
        if (XEN(5) && IN_PH()) for (int rep = 0; rep < XREP(5); ++rep) { PIN_TID();
            pg8::Gemm g{CAT, WOUT + (size_t)l * DM * DM, M, DM, DM}; pg8::StaticOrder S; S.init(M, DM, G, (int)blockIdx.x);
            pg8::EpiBf E{F32, DM};
            pg8::gemm_phase<pg8::EpiBf, pg8::StaticOrder, PG8ALIGN, PG8SP2>(lds, g, S, E);
        }
        SEAM();
        if (XEN(6) && IN_PH()) for (int rep = 0; rep < XREP(6); ++rep) { PIN_TID(); if (XREP(6) > 1 && rep == 0) norm_rows<false, true>(F32, XN, karg(14) + l * DM, RS, nullptr, gw, NGW, lane, PROJ); else norm_rows<false>(F32, XN, karg(14) + l * DM, RS, nullptr, gw, NGW, lane); }
        SEAM();
        if (XEN(7) && IN_PH()) for (int rep = 0; rep < XREP(7); ++rep) { PIN_TID();
            pg8::Gemm g{XN, WGU + (size_t)l * NGU * DM, M, NGU, DM}; pg8::StaticOrder S; S.init(M, NGU, G, (int)blockIdx.x);
            pg8::EpiSwiGLU E{HID, FFH, RS};
            pg8::gemm_phase<pg8::EpiSwiGLU, pg8::StaticOrder, PG8ALIGN, PG8SP2>(lds, g, S, E);
        }
        SEAM();
        if (XEN(8) && IN_PH()) for (int rep = 0; rep < XREP(8); ++rep) { PIN_TID();
            pg8::Gemm g{HID, WDN + (size_t)l * DM * FFH, M, DM, FFH}; pg8::StaticOrder S; S.init(M, DM, G, (int)blockIdx.x);
            pg8::EpiBf E{F32, DM};
            pg8::gemm_phase<pg8::EpiBf, pg8::StaticOrder, PG8ALIGN, PG8SP2>(lds, g, S, E);
        }
        SEAM();
        if (XEN(9) && IN_PH()) for (int rep = 0; rep < XREP(9); ++rep) { PIN_TID(); if (XREP(9) > 1 && rep == 0) norm_rows<false, true>(F32, XN, karg(19) + l * DM, RS, nullptr, gw, NGW, lane, PROJ); else if (l + 1 < DEPTH) norm_rows<false>(F32, XN, karg(19) + l * DM, RS, nullptr, gw, NGW, lane); else norm_rows<true>(F32, XN, karg(19) + l * DM, nullptr, out, gw, NGW, lane); }
        SEAM();
    }
}
#undef lambda_init
#undef out
#undef x_in
#undef ctl
constexpr int N_PHASES = 1 + 8 * DEPTH;

extern "C" void kernel_launch(void* const* d_in, const int* in_sizes, int n_in, void* d_out, int out_size, void* d_ws, size_t ws_size, hipStream_t stream) {
    static int grid = 0;
    if (grid == 0) {
        if (n_in != 20 || in_sizes[0] != M * DM || out_size != M * DM || ws_size < WS_END) { fprintf(stderr, "kernel_launch: unexpected shapes / workspace (n_in %d, in0 %d, out %d, ws %zu)\n", n_in, n_in > 0 ? in_sizes[0] : -1, out_size, ws_size); grid = -1; return; }
        int dev = 0, cus = 0, per_cu = 0;
        if (hipGetDevice(&dev) != hipSuccess || hipDeviceGetAttribute(&cus, hipDeviceAttributeMultiprocessorCount, dev) != hipSuccess) { grid = -1; return; }
        if (hipFuncSetAttribute((const void*)fwd, hipFuncAttributeMaxDynamicSharedMemorySize, LDS_BYTES) != hipSuccess) { fprintf(stderr, "kernel_launch: hipFuncSetAttribute failed\n"); grid = -1; return; }
        if (hipOccupancyMaxActiveBlocksPerMultiprocessor(&per_cu, (const void*)fwd, NTHR, LDS_BYTES) != hipSuccess || per_cu < 1) { fprintf(stderr, "kernel_launch: occupancy query says %d\n", per_cu); per_cu = 1; }
        (void)hipGetLastError();
        grid = cus * (per_cu > 1 ? 1 : per_cu);
    }
    if (grid < 0) return;
    (void)hipMemsetAsync((char*)d_ws + WS_CTL, 0, CTL_ZERO_BYTES, stream);
    Args a{};
    for (int i = 0; i < 20; ++i) a.in[i] = (const float*)d_in[i];
    a.out = (float*)d_out; a.ws = (unsigned char*)d_ws;
#if MK_ONE_LAUNCH
    a.ph_lo = 0; a.ph_hi = N_PHASES;
    void* kargs[] = {&a};
    hipError_t e = hipLaunchCooperativeKernel((const void*)fwd, dim3(grid), dim3(NTHR), kargs, LDS_BYTES, stream);
    if (e != hipSuccess) fprintf(stderr, "kernel_launch: cooperative launch failed: %s (grid %d)\n", hipGetErrorString(e), grid);
#else
    for (int p = 0; p < N_PHASES; ++p) { a.ph_lo = p; a.ph_hi = p + 1; hipLaunchKernelGGL(fwd, dim3(grid), dim3(NTHR), LDS_BYTES, stream, a); }
#endif
}
```

```cpp
#include <hip/hip_runtime.h>
#include <hip/hip_cooperative_groups.h>
#include <hip/hip_bf16.h>
#include <cstdio>
#include <cstdint>
#include <cmath>
namespace pg8 {
#define PG8_LAS __attribute__((address_space(3)))
typedef unsigned short bf16_t;
typedef short bf16x8 __attribute__((ext_vector_type(8)));
typedef float f32x4 __attribute__((ext_vector_type(4)));
typedef unsigned u32x4 __attribute__((ext_vector_type(4)));
constexpr int BM = 256, BK = 64, HALF = 128, HTB = HALF * BK * 2  , STAGE_BYTES = 8 * HTB, NXCD = 8, WGM = 8;

__host__ __device__ __forceinline__ int lds_byte(int r, int c) { const int st = (r >> 4) * 2 + (c >> 5), rr = r & 15, cc = c & 31, ob = rr * 64 + cc * 2; return st * 1024 + (ob ^ (((ob >> 9) & 1) << 5)); }
__host__ __device__ __forceinline__ void stage_rc(int b, int& R, int& C) { const int st = b / 1024, sb = b % 1024, swz = sb ^ (((sb >> 9) & 1) << 5); R = (st >> 1) * 16 + swz / 64; C = (st & 1) * 32 + (swz % 64) / 2; }
__host__ __device__ __forceinline__ int perm32(int rho) { const int n = rho >> 4, i = rho & 15; return 8 * (i >> 2) + 4 * n + (i & 3); }

struct Unit { int pm, pn; };
struct Gemm { const bf16_t* A; const bf16_t* Bt; int M, N, K; };

struct StaticOrder {
    int nM, nN, nwg, G, c;
    __host__ __device__ void init(int M, int N, int G_, int c_) { nM = M / BM; nN = N / BM; nwg = nM * nN; G = G_; c = c_; }
    __host__ __device__ bool next(int i, Unit& u) const {
        const long L = (long)i * G + c; if (L >= nwg) return false;
        int wgid = (int)L; { const int q = nwg / NXCD, r = nwg % NXCD, xcd = wgid % NXCD, off = wgid / NXCD; wgid = (xcd < r ? xcd * (q + 1) : r * (q + 1) + (xcd - r) * q) + off; }
        const int nig = WGM * nN, gid = wgid / nig, fm = gid * WGM, gsz = (nM - fm) < WGM ? (nM - fm) : WGM;
        u.pm = fm + ((wgid % nig) % gsz); u.pn = (wgid % nig) / gsz; return true;
    }
    __device__ __forceinline__ void a_ready(const Unit&) const {}
    __device__ __forceinline__ void done(const Unit&) const {}
};

typedef float f32x2c_t __attribute__((ext_vector_type(2))); typedef __bf16 bf16x2c_t __attribute__((ext_vector_type(2)));
__device__ __forceinline__ unsigned cvt_pk_bf16(float lo, float hi) { f32x2c_t v = {lo, hi}; bf16x2c_t b = __builtin_convertvector(v, bf16x2c_t); return __builtin_bit_cast(unsigned, b); }
typedef float f32x2 __attribute__((ext_vector_type(2)));
struct OneUnit {
    int pm, pn;
    __device__ __forceinline__ bool next(int i, Unit& u) const { if (i) return false; u.pm = pm; u.pn = pn; return true; }
    __device__ __forceinline__ void a_ready(const Unit&) const {}
    __device__ __forceinline__ void done(const Unit&) const {}
};
struct EpiProj {
    static constexpr bool PERM = true, AFTER_DRAIN = false;
    bf16_t* O; int ldc; const float* rs;
    __device__ __forceinline__ void operator()(const f32x4 (&acc)[2][2][4][2], const Unit& u, int wr, int wc, int fr, int fq) const {
        const float sc0 = (u.pn >= 3 && u.pn < 6) ? 0.08838834764831845f : ((u.pn >= 12 && u.pn < 15) ? 0.125f * 1.4426950408889634f : 1.f);
        const int row0 = u.pm * BM + wr * 64 + fr, col0 = u.pn * BM + wc * 32 + 8 * fq;
#pragma unroll
        for (int ai = 0; ai < 2; ++ai)
#pragma unroll
            for (int m = 0; m < 4; ++m) { bf16_t* rowp = O + (size_t)(row0 + ai * HALF + m * 16) * ldc + col0; const float sc = sc0 * rs[row0 + ai * HALF + m * 16];
#pragma unroll
                for (int bj = 0; bj < 2; ++bj) { const f32x4 v0 = acc[ai][bj][m][0] * sc, v1 = acc[ai][bj][m][1] * sc;
                    u32x4 w; w.x = cvt_pk_bf16(v0[0], v0[1]); w.y = cvt_pk_bf16(v0[2], v0[3]); w.z = cvt_pk_bf16(v1[0], v1[1]); w.w = cvt_pk_bf16(v1[2], v1[3]);
                    *(u32x4*)(rowp + bj * HALF) = w; } }
    }
};
struct EpiBf {
    static constexpr bool PERM = true, AFTER_DRAIN = false;
    bf16_t* O; int ldc;
    __device__ __forceinline__ void operator()(const f32x4 (&acc)[2][2][4][2], const Unit& u, int wr, int wc, int fr, int fq) const {
        const int row0 = u.pm * BM + wr * 64 + fr, col0 = u.pn * BM + wc * 32 + 8 * fq;
#pragma unroll
        for (int ai = 0; ai < 2; ++ai)
#pragma unroll
            for (int m = 0; m < 4; ++m) { bf16_t* rowp = O + (size_t)(row0 + ai * HALF + m * 16) * ldc + col0;
#pragma unroll
                for (int bj = 0; bj < 2; ++bj) { const f32x4 v0 = acc[ai][bj][m][0], v1 = acc[ai][bj][m][1];
                    u32x4 w; w.x = cvt_pk_bf16(v0[0], v0[1]); w.y = cvt_pk_bf16(v0[2], v0[3]); w.z = cvt_pk_bf16(v1[0], v1[1]); w.w = cvt_pk_bf16(v1[2], v1[3]);
                    *(u32x4*)(rowp + bj * HALF) = w; } }
    }
};
struct EpiF32 {
    static constexpr bool PERM = false, AFTER_DRAIN = false;
    float* O; int ldc;
    __device__ __forceinline__ void operator()(const f32x4 (&acc)[2][2][4][2], const Unit& u, int wr, int wc, int fr, int fq) const {
        const int col0 = u.pn * BM + wc * 32 + 4 * fq;
#pragma unroll
        for (int ai = 0; ai < 2; ++ai)
#pragma unroll
            for (int m = 0; m < 4; ++m) { float* rowp = O + (size_t)(u.pm * BM + ai * HALF + wr * 64 + m * 16 + fr) * ldc + col0;
#pragma unroll
                for (int bj = 0; bj < 2; ++bj)
#pragma unroll
                    for (int n = 0; n < 2; ++n) *(f32x4*)(rowp + bj * HALF + n * 16) = acc[ai][bj][m][n]; }
    }
};
struct EpiSwiGLU {
    static constexpr bool PERM = true, AFTER_DRAIN = false;
    bf16_t* O; int ldc; const float* rs;
    __device__ __forceinline__ static float sw(float g, float u) { return g * __builtin_amdgcn_rcpf(1.f + __builtin_amdgcn_exp2f(-1.4426950408889634f * g)) * u; }
    __device__ __forceinline__ void operator()(const f32x4 (&acc)[2][2][4][2], const Unit& u, int wr, int wc, int fr, int fq) const {
        const int row0 = u.pm * BM + wr * 64 + fr, col0 = u.pn * HALF + wc * 32 + 8 * fq;
#pragma unroll
        for (int ai = 0; ai < 2; ++ai)
#pragma unroll
            for (int m = 0; m < 4; ++m) { bf16_t* rowp = O + (size_t)(row0 + ai * HALF + m * 16) * ldc + col0;
                const float r_ = rs[row0 + ai * HALF + m * 16];
                const f32x4 g0 = acc[ai][0][m][0] * r_, g1 = acc[ai][0][m][1] * r_, u0 = acc[ai][1][m][0] * r_, u1 = acc[ai][1][m][1] * r_;
                u32x4 w; w.x = cvt_pk_bf16(sw(g0[0], u0[0]), sw(g0[1], u0[1])); w.y = cvt_pk_bf16(sw(g0[2], u0[2]), sw(g0[3], u0[3]));
                w.z = cvt_pk_bf16(sw(g1[0], u1[0]), sw(g1[1], u1[1])); w.w = cvt_pk_bf16(sw(g1[2], u1[2]), sw(g1[3], u1[3]));
                *(u32x4*)rowp = w; }
    }
};

template <class Epi, class Sched, bool ALIGN_EPI = false, bool SP2 = false>
__device__ __forceinline__ void gemm_phase(PG8_LAS unsigned char* lds, const Gemm g, const Sched& S, const Epi& E) {
    int tid = threadIdx.x; asm volatile("" : "+v"(tid)); const int wid = __builtin_amdgcn_readfirstlane(tid >> 6), lane = tid & 63, wr = wid >> 2, wc = wid & 3, fr = lane & 15, fq = lane >> 4;
    const int K = g.K, nt = K / BK;
    unsigned voffA[2], voffB[2];
#pragma unroll
    for (int i = 0; i < 2; ++i) { int R, C; stage_rc(tid * 16 + i * 8192, R, C); const int Rb = Epi::PERM ? ((R & ~31) + perm32(R & 31)) : R;
        voffA[i] = (unsigned)(R * K + C) * 2u; voffB[i] = (unsigned)(Rb * K + C) * 2u; }
    const size_t kstep = (size_t)(BK * 2);
    const size_t hstep = (size_t)HALF * K * 2;
    const size_t tstep = 2 * hstep;
    const unsigned ldsw = (unsigned)wid * 1024u;
    const int aoff = lds_byte(wr * 64 + fr, fq * 8), boff = lds_byte(wc * 32 + fr, fq * 8);
#define PG8_SA(b, h) (((b) * 2 + (h)) * HTB)
#define PG8_SB(b, h) ((4 + (b) * 2 + (h)) * HTB)
#define PG8_STAGE(bufoff, gbase, voff) do { _Pragma("unroll") for (int _i = 0; _i < 2; ++_i) \
        __builtin_amdgcn_global_load_lds((const unsigned*)((const char*)(gbase) + (voff)[_i]), (PG8_LAS unsigned*)(lds + (bufoff) + ldsw + _i * 8192), 16, 0, 0); } while (0)
#define PG8_LDA(dst, b, h) do { _Pragma("unroll") for (int m = 0; m < 4; ++m) _Pragma("unroll") for (int k = 0; k < 2; ++k) dst[m][k] = *(const PG8_LAS bf16x8*)(lds + PG8_SA(b, h) + aoff + m * 2048 + k * 1024); } while (0)
#define PG8_LDB(dst, b, h) do { _Pragma("unroll") for (int n = 0; n < 2; ++n) _Pragma("unroll") for (int k = 0; k < 2; ++k) dst[n][k] = *(const PG8_LAS bf16x8*)(lds + PG8_SB(b, h) + boff + n * 2048 + k * 1024); } while (0)
#define PG8_MMA(ai, bj, At, Bt) do { __builtin_amdgcn_s_setprio(1); _Pragma("unroll") for (int m = 0; m < 4; ++m) _Pragma("unroll") for (int n = 0; n < 2; ++n) _Pragma("unroll") for (int k = 0; k < 2; ++k) \
        acc[ai][bj][m][n] = __builtin_amdgcn_mfma_f32_16x16x32_bf16(Bt[n][k], At[m][k], acc[ai][bj][m][n], 0, 0, 0); __builtin_amdgcn_s_setprio(0); } while (0)
#define PG8_WAIT_V(n) asm volatile("s_waitcnt vmcnt(" #n ")" ::: "memory")
#define PG8_WAIT_L(n) asm volatile("s_waitcnt lgkmcnt(" #n ")" ::: "memory")
#define PG8_BAR __builtin_amdgcn_s_barrier()
#define PG8_SCHED __builtin_amdgcn_sched_barrier(0)
    Unit cur, nxt; int ui = 0;
    if (!S.next(0, cur)) return;
    f32x4 acc[2][2][4][2];
#pragma unroll
    for (int a = 0; a < 2; ++a)
#pragma unroll
        for (int b = 0; b < 2; ++b)
#pragma unroll
            for (int m = 0; m < 4; ++m)
#pragma unroll
                for (int n = 0; n < 2; ++n) acc[a][b][m][n] = (f32x4){0.f, 0.f, 0.f, 0.f};
    bf16x8 At[4][2], B0[2][2], B1[2][2];
    const char* cA = (const char*)g.A + (size_t)cur.pm * tstep; const char* cB = (const char*)g.Bt + (size_t)cur.pn * tstep;
    S.a_ready(cur);
    if constexpr (SP2) {
        PG8_STAGE(PG8_SB(0, 0), cB, voffB); PG8_STAGE(PG8_SB(0, 1), cB + hstep, voffB); PG8_STAGE(PG8_SA(0, 0), cA, voffA); PG8_STAGE(PG8_SA(0, 1), cA + hstep, voffA);
        if (wr == 1) PG8_BAR;
        PG8_WAIT_V(2); PG8_BAR;
        PG8_STAGE(PG8_SB(1, 0), cB + kstep, voffB); PG8_STAGE(PG8_SA(1, 0), cA + kstep, voffA); PG8_STAGE(PG8_SB(1, 1), cB + hstep + kstep, voffB);
        PG8_WAIT_V(6); PG8_BAR;
    } else {
        PG8_STAGE(PG8_SB(0, 0), cB, voffB); PG8_STAGE(PG8_SA(0, 0), cA, voffA); PG8_STAGE(PG8_SB(0, 1), cB + hstep, voffB); PG8_STAGE(PG8_SA(0, 1), cA + hstep, voffA);
        if (wr == 1) PG8_BAR;
        PG8_WAIT_V(4); PG8_BAR;
        PG8_STAGE(PG8_SB(1, 0), cB + kstep, voffB); PG8_STAGE(PG8_SA(1, 0), cA + kstep, voffA); PG8_STAGE(PG8_SB(1, 1), cB + hstep + kstep, voffB);
        PG8_WAIT_V(6); PG8_BAR;
    }
    for (;;) {
        const bool has_next = S.next(ui + 1, nxt);
        const char* nA = has_next ? (const char*)g.A + (size_t)nxt.pm * tstep : cA; const char* nB = has_next ? (const char*)g.Bt + (size_t)nxt.pn * tstep : cB;
        for (int t = 0; t < nt; t += 2) {
            const bool last = (t == nt - 2);
            const char* a1 = cA + (size_t)(t + 1) * kstep;
            const char* a2 = last ? nA : cA + (size_t)(t + 2) * kstep; const char* b2 = last ? nB : cB + (size_t)(t + 2) * kstep;
            const char* a3 = a2 + kstep; const char* b3 = b2 + kstep;
            if (last && has_next) S.a_ready(nxt);
            if constexpr (SP2) {
            PG8_LDB(B0, 0, 0); PG8_LDB(B1, 0, 1); PG8_SCHED; PG8_LDA(At, 0, 0); PG8_STAGE(PG8_SA(1, 1), a1 + hstep, voffA);
            PG8_WAIT_V(8); PG8_WAIT_L(0); PG8_BAR; PG8_MMA(0, 0, At, B0); PG8_MMA(0, 1, At, B1); PG8_BAR; PG8_SCHED;
            PG8_LDA(At, 0, 1); PG8_STAGE(PG8_SB(0, 0), b2, voffB); PG8_STAGE(PG8_SB(0, 1), b2 + hstep, voffB); PG8_STAGE(PG8_SA(0, 0), a2, voffA);
            PG8_WAIT_V(8); PG8_WAIT_L(0); PG8_BAR; PG8_MMA(1, 0, At, B0); PG8_MMA(1, 1, At, B1); PG8_BAR; PG8_SCHED;
            PG8_LDB(B0, 1, 0); PG8_LDB(B1, 1, 1); PG8_SCHED; PG8_LDA(At, 1, 0); PG8_STAGE(PG8_SA(0, 1), a2 + hstep, voffA);
            PG8_WAIT_V(8); PG8_WAIT_L(0); PG8_BAR; PG8_MMA(0, 0, At, B0); PG8_MMA(0, 1, At, B1); PG8_BAR; PG8_SCHED;
            PG8_LDA(At, 1, 1); PG8_STAGE(PG8_SB(1, 0), b3, voffB); PG8_STAGE(PG8_SB(1, 1), b3 + hstep, voffB); PG8_STAGE(PG8_SA(1, 0), a3, voffA);
            PG8_WAIT_V(8); PG8_WAIT_L(0); PG8_BAR; PG8_MMA(1, 0, At, B0); PG8_MMA(1, 1, At, B1); PG8_BAR; PG8_SCHED;
            } else {
            PG8_LDB(B0, 0, 0); PG8_SCHED; PG8_LDA(At, 0, 0); PG8_STAGE(PG8_SA(1, 1), a1 + hstep, voffA);
            PG8_WAIT_L(8); PG8_BAR; PG8_WAIT_L(0); PG8_MMA(0, 0, At, B0); PG8_BAR; PG8_SCHED;
            PG8_LDB(B1, 0, 1); PG8_STAGE(PG8_SB(0, 0), b2, voffB);
            PG8_BAR; PG8_WAIT_L(0); PG8_MMA(0, 1, At, B1); PG8_BAR;
            PG8_LDA(At, 0, 1); PG8_STAGE(PG8_SA(0, 0), a2, voffA);
            PG8_BAR; PG8_WAIT_L(0); PG8_MMA(1, 0, At, B0); PG8_BAR; PG8_SCHED;
            PG8_STAGE(PG8_SB(0, 1), b2 + hstep, voffB);
            PG8_WAIT_V(6); PG8_BAR; PG8_MMA(1, 1, At, B1); PG8_BAR;
            PG8_LDB(B0, 1, 0); PG8_SCHED; PG8_LDA(At, 1, 0); PG8_STAGE(PG8_SA(0, 1), a2 + hstep, voffA);
            PG8_WAIT_L(8); PG8_BAR; PG8_WAIT_L(0); PG8_MMA(0, 0, At, B0); PG8_BAR; PG8_SCHED;
            PG8_LDB(B1, 1, 1); PG8_STAGE(PG8_SB(1, 0), b3, voffB);
            PG8_BAR; PG8_WAIT_L(0); PG8_MMA(0, 1, At, B1); PG8_BAR;
            PG8_LDA(At, 1, 1); PG8_STAGE(PG8_SA(1, 0), a3, voffA);
            PG8_BAR; PG8_WAIT_L(0); PG8_MMA(1, 0, At, B0); PG8_BAR; PG8_SCHED;
            PG8_STAGE(PG8_SB(1, 1), b3 + hstep, voffB);
            PG8_WAIT_V(6); PG8_BAR; PG8_MMA(1, 1, At, B1); PG8_BAR;
            }
        }
        if constexpr (ALIGN_EPI) { if (wr == 0) PG8_BAR; }
        if constexpr (!Epi::AFTER_DRAIN) { E(acc, cur, wr, wc, fr, fq); S.done(cur); }
        if (!has_next) break;
#pragma unroll
        for (int a = 0; a < 2; ++a)
#pragma unroll
            for (int b = 0; b < 2; ++b)
#pragma unroll
                for (int m = 0; m < 4; ++m)
#pragma unroll
                    for (int n = 0; n < 2; ++n) acc[a][b][m][n] = (f32x4){0.f, 0.f, 0.f, 0.f};
        cur = nxt; cA = nA; cB = nB; ++ui;
        if constexpr (ALIGN_EPI) { if (wr == 1) PG8_BAR; }
    }
    PG8_WAIT_V(0);
    if constexpr (!ALIGN_EPI) { if (wr == 0) PG8_BAR; }
    PG8_BAR;
    if constexpr (Epi::AFTER_DRAIN) { E.fused(acc, cur, wr, wc, fr, fq, lds, wid, lane); S.done(cur); }
#undef PG8_SA
#undef PG8_SB
#undef PG8_STAGE
#undef PG8_LDA
#undef PG8_LDB
#undef PG8_MMA
#undef PG8_WAIT_V
#undef PG8_WAIT_L
#undef PG8_BAR
#undef PG8_SCHED
}
}

namespace attn_body {
using bf16=__hip_bfloat16;
using bf16x8=__attribute__((ext_vector_type(8)))short;
using s16x4=__attribute__((ext_vector_type(4)))short;
using f32x16=__attribute__((ext_vector_type(16)))float;
using u32x4=__attribute__((ext_vector_type(4)))unsigned;
constexpr int BATCH=2,SEQ=8192,D=64,DM=6400;
constexpr int NW=8,QBLK=32,QB=QBLK*NW,KVBLK=64,NQB=SEQ/QB;
constexpr int ATTN_PITCH=DM, ATTN_UNIT_ROWS=QB;
__device__ __forceinline__ int crow(int r,int hi){return (r&3)+8*(r>>2)+4*hi;}
#define SBAR() __builtin_amdgcn_sched_barrier(0)
__device__ __forceinline__ void cmask(f32x16&p0,f32x16&p1,int jb,int qrel,int hi){
  const float NEG=-INFINITY; int kb=64*jb+4*hi;
  #pragma unroll
  for(int r=0;r<16;++r){int kv=kb+(r&3)+8*(r>>2); if(kv>qrel)p0[r]=NEG; if(kv+32>qrel)p1[r]=NEG;}
}

constexpr int NSLOT=3, SLOTB=8192;
constexpr int LDS_K=0, LDS_V=NSLOT*SLOTB, LDS_WS=3*NSLOT*SLOTB, LDS_OST=LDS_WS+NW*64*4, LDS_BYTES=LDS_OST+NW*4096;
constexpr float C2=0.125f*1.4426950408889634f;
__device__ __forceinline__ void glds16(const void*gsrc,unsigned lds_dst){unsigned keep;
  asm volatile("s_mov_b32 %0, m0\n\ts_mov_b32 m0, %2\n\ts_nop 0\n\tglobal_load_lds_dwordx4 %1, off\n\ts_mov_b32 m0, %0":"=&s"(keep):"v"(gsrc),"s"(lds_dst):"memory");}
__device__ __forceinline__ float max3f(float a,float b,float c){float r;asm("v_max3_f32 %0, %1, %2, %3":"=v"(r):"v"(a),"v"(b),"v"(c));return r;}
__device__ __forceinline__ float max2f(float a,float b){float r;asm("v_max_f32_e32 %0, %1, %2":"=v"(r):"v"(a),"v"(b));return r;}
__device__ __forceinline__ float fadd_s(float a,float b){float r;asm("v_add_f32_e32 %0, %1, %2":"=v"(r):"v"(a),"v"(b));return r;}
__device__ __forceinline__ float fsub_s(float a,float b){float r;asm("v_sub_f32_e32 %0, %1, %2":"=v"(r):"v"(a),"v"(b));return r;}
typedef float f32x2_t __attribute__((ext_vector_type(2))); typedef __bf16 bf16x2_t __attribute__((ext_vector_type(2)));
__device__ __forceinline__ unsigned cvtpk_s(float lo,float hi){f32x2_t v={lo,hi};bf16x2_t b=__builtin_convertvector(v,bf16x2_t);return __builtin_bit_cast(unsigned,b);}
#define WAIT_BAR(N) asm volatile("s_waitcnt vmcnt(" #N ") lgkmcnt(0)\n\ts_barrier":::"memory")

__device__ __forceinline__ void qkt(f32x16&p0,f32x16&p1,const char*Kslot,const bf16x8*qr,int r32,int hi){
  const char*kb=Kslot+hi*1024+r32*16;
  #pragma unroll
  for(int d0=0;d0<4;++d0){
    const bf16x8 b0=*reinterpret_cast<const bf16x8*>(kb+d0*2048);
    const bf16x8 b1=*reinterpret_cast<const bf16x8*>(kb+d0*2048+512);
    {p0=__builtin_amdgcn_mfma_f32_32x32x16_bf16(b0,qr[d0],p0,0,0,0);p1=__builtin_amdgcn_mfma_f32_32x32x16_bf16(b1,qr[d0],p1,0,0,0);}}
}
typedef __attribute__((address_space(3))) const char* lds_cptr;
typedef short v4i16_t __attribute__((ext_vector_type(4)));
__device__ __forceinline__ void kload8(bf16x8*kf,lds_cptr kp){
  kf[0]=*(const __attribute__((address_space(3))) bf16x8*)(kp);      kf[1]=*(const __attribute__((address_space(3))) bf16x8*)(kp+512);
  kf[2]=*(const __attribute__((address_space(3))) bf16x8*)(kp+2048); kf[3]=*(const __attribute__((address_space(3))) bf16x8*)(kp+2560);
  kf[4]=*(const __attribute__((address_space(3))) bf16x8*)(kp+4096); kf[5]=*(const __attribute__((address_space(3))) bf16x8*)(kp+4608);
  kf[6]=*(const __attribute__((address_space(3))) bf16x8*)(kp+6144); kf[7]=*(const __attribute__((address_space(3))) bf16x8*)(kp+6656);
}
__device__ __forceinline__ void kload2(bf16x8*kf,lds_cptr kp,int j){ kf[2*j]=*(const __attribute__((address_space(3))) bf16x8*)(kp+j*2048); kf[2*j+1]=*(const __attribute__((address_space(3))) bf16x8*)(kp+j*2048+512); }
__device__ __forceinline__ s16x4 vtr(lds_cptr p){ return __builtin_bit_cast(s16x4,__builtin_amdgcn_ds_read_tr16_b64_v4i16((__attribute__((address_space(3))) v4i16_t*)p)); }
__device__ __forceinline__ float rowmax(const f32x16&p0,const f32x16&p1){
  float a=max3f(p0[0],p0[1],p1[0]),b=max3f(p0[2],p0[3],p1[1]);a=max3f(a,p1[2],p1[3]);
  #pragma unroll
  for(int r=4;r<16;r+=4){a=max3f(a,p0[r],p0[r+1]);b=max3f(b,p0[r+2],p0[r+3]);a=max3f(a,p1[r],p1[r+1]);b=max3f(b,p1[r+2],p1[r+3]);}
  const float m=max2f(a,b);
  auto rr=__builtin_amdgcn_permlane32_swap(__float_as_uint(m),__float_as_uint(m),false,false);
  return max2f(__uint_as_float(rr[0]),__uint_as_float(rr[1]));
}
__device__ __forceinline__ void pv(f32x16*o,int vb,bf16x8 pa0,bf16x8 pa1,bf16x8 pa2,bf16x8 pa3){
  #pragma unroll
  for(int d0=0;d0<4;++d0){s16x4 lo[4],hi[4];
    #pragma unroll
    for(int ks=0;ks<4;++ks){
      asm volatile("ds_read_b64_tr_b16 %0,%1 offset:%c2":"=&v"(lo[ks]):"v"(vb),"i"(d0*4096+ks*1024):"memory");
      asm volatile("ds_read_b64_tr_b16 %0,%1 offset:%c2":"=&v"(hi[ks]):"v"(vb),"i"(d0*4096+ks*1024+512):"memory");}
    asm volatile("s_waitcnt lgkmcnt(0)":::"memory");SBAR();
    #define PK(k) (bf16x8){lo[k][0],lo[k][1],lo[k][2],lo[k][3],hi[k][0],hi[k][1],hi[k][2],hi[k][3]}
    o[d0]=__builtin_amdgcn_mfma_f32_32x32x16_bf16(pa0,PK(0),o[d0],0,0,0);
    o[d0]=__builtin_amdgcn_mfma_f32_32x32x16_bf16(pa1,PK(1),o[d0],0,0,0);
    o[d0]=__builtin_amdgcn_mfma_f32_32x32x16_bf16(pa2,PK(2),o[d0],0,0,0);
    o[d0]=__builtin_amdgcn_mfma_f32_32x32x16_bf16(pa3,PK(3),o[d0],0,0,0);
    #undef PK
  }
}

#ifndef ATTN_STORE16
#define ATTN_STORE16(p,v) (*(u32x4*)(p)=(v))
#endif
template<int THRL> __device__ __forceinline__ void attn_unit(int b,int qb,int T0,const bf16*Q,const bf16*__restrict__ K,const bf16*__restrict__ V,float*Dg,float cs,float lam,char*shm){
  int tid=threadIdx.x; asm volatile("":"+v"(tid)); const int lane=tid&63,r32=lane&31,hi=lane>>5; const int wid=__builtin_amdgcn_readfirstlane(tid>>6);
  const long rowbase=(long)b*SEQ; const int q0=qb*QB;
  const bf16*Qw=Q+(rowbase+q0+wid*QBLK)*DM;
  const bf16*Kh=K+(rowbase+(long)T0*KVBLK)*DM,*Vh=V+(rowbase+(long)T0*KVBLK)*DM;
  const unsigned lds0=(unsigned)(uintptr_t)shm;
  float*wsf=(float*)(shm+LDS_WS)+wid*64;
  const bf16*ksrc=Kh+(long)lane*DM+wid*8;
  const bf16*vsrc=Vh+(long)(16*(wid&3)+(lane>>2))*DM+(wid>>2)*32+(lane&3)*8;
  const unsigned kdst=lds0+LDS_K+wid*1024, vdst=lds0+LDS_V+wid*1024;
  #define DMA_K(t,slot) glds16(ksrc+(long)(t)*KVBLK*DM,(unsigned)__builtin_amdgcn_readfirstlane(kdst+(slot)))
  #define DMA_V(t,slot) do{ glds16(vsrc+(long)(t)*KVBLK*DM,(unsigned)__builtin_amdgcn_readfirstlane(vdst+2*(slot))); glds16(vsrc+(long)(t)*KVBLK*DM+64,(unsigned)__builtin_amdgcn_readfirstlane(vdst+2*(slot)+8192)); }while(0)
  const int vb0=(int)(lds0+LDS_V)+((lane>>4)&1)*32+(lane&3)*8+(4*hi+((lane&15)>>2))*64;
  const char*Kbase=shm+LDS_K; bf16x8 kf[8];
  const lds_cptr shm3=(lds_cptr)shm; const lds_cptr kp0=shm3+LDS_K+hi*1024+r32*16; const lds_cptr vp0=shm3+LDS_V+((lane>>4)&1)*32+(lane&3)*8+(4*hi+((lane&15)>>2))*64;
  const int NT=(q0+QB)/KVBLK-T0;
  DMA_K(0,0);DMA_V(0,0);DMA_K(1,SLOTB);
  bf16x8 qr[4];
  #pragma unroll
  for(int d0=0;d0<4;++d0)qr[d0]=*reinterpret_cast<const bf16x8*>(&Qw[(long)r32*DM+d0*16+hi*8]);
  float mhat=0.f,l_reg=0.f;f32x16 o[4];o[0]=f32x16{};o[1]=f32x16{};o[2]=f32x16{};o[3]=f32x16{};const float cs32=cs*32.f; const float kb0=cs*(float)(4*hi-(q0+QB)+KVBLK*T0);
  #define BIN0(C0) do{ _Pragma("unroll") for(int r=0;r<16;++r)C0[r]=__builtin_fmaf(cs,(float)((r&3)+8*(r>>2)),sc_); }while(0)
  #define BIN1(C1) do{ _Pragma("unroll") for(int r=0;r<16;++r)C1[r]=__builtin_fmaf(cs,(float)((r&3)+8*(r>>2)),sc_+cs32); }while(0)
  const int qrel=wid*QBLK+r32;
  #define CMASK(P0,P1,t) do{int jb_=(t)-(NT-4); if(jb_>=0)cmask(P0,P1,jb_,qrel,hi);}while(0)
  bool resc=false;
  #define START(P0,P1) do{ const float rm=rowmax(P0,P1); resc=false; \
    { const float dl=rm; mhat=fadd_s(mhat,dl); \
      _Pragma("unroll") for(int r=0;r<16;++r){P0[r]=fsub_s(P0[r],dl);P1[r]=fsub_s(P1[r],dl);} \
      } \
    _Pragma("unroll") for(int r=0;r<16;++r)P0[r]=__builtin_amdgcn_exp2f(P0[r]); }while(0)
  #define RESC() do{ if(resc){ asm volatile("s_waitcnt lgkmcnt(0)":::"memory"); \
      _Pragma("unroll") for(int d_=0;d_<4;++d_) _Pragma("unroll") for(int r=0;r<16;++r)o[d_][r]*=wsf[crow(r,hi)]; } }while(0)
  f32x16 pA0,pA1,pB0,pB1;
  int sl_prev=0,sl_cur=0,sl_next=SLOTB;
  #define ROT() do{sl_prev=sl_cur;sl_cur=sl_next;sl_next=(sl_next==(NSLOT-1)*SLOTB)?0:sl_next+SLOTB;}while(0)
  DMA_K(2,2*SLOTB);
  WAIT_BAR(4);
  SBAR(); {float sc_=kb0-mhat; asm volatile("":"+v"(sc_)); BIN0(pA0); BIN1(pA1);} SBAR(); qkt(pA0,pA1,Kbase,qr,r32,hi);asm volatile("s_nop 15\n\ts_nop 7":"+v"(pA0),"+v"(pA1));CMASK(pA0,pA1,0);
  START(pA0,pA1);
  _Pragma("unroll") for(int r=0;r<16;++r)pA1[r]=__builtin_amdgcn_exp2f(pA1[r]);
  WAIT_BAR(0);
  DMA_K(3,0);DMA_V(1,SLOTB);
  ROT();
  kload8(kf,kp0+sl_cur);
  WAIT_BAR(3);
  s16x4 vlo[8],vhi[8]; u32x4 pw0,pw1,pw2,pw3;
  #define PKW(P,B) cvtpk_s(P[B],P[B+1])
  #define PAF(k) __builtin_bit_cast(bf16x8,pw##k)
  #define VFR(i) (bf16x8){vlo[i][0],vlo[i][1],vlo[i][2],vlo[i][3],vhi[i][0],vhi[i][1],vhi[i][2],vhi[i][3]}
  #define PIN(x) asm volatile("":"+v"(x))
  #define MX3(a,b,c) __builtin_fmaxf(__builtin_fmaxf((a),(b)),(c))
  #define GAPA(MF,A0,A1,A2,A3,W0,W1,PW) do{ MF; sacc+=A0; sacc+=A1; sacc+=A2; sacc+=A3; PIN(sacc); W0; W1; PIN(PW); SBAR(); }while(0)
  #define EX(v) __builtin_amdgcn_exp2f(v)
  #define GAPB(MF,X,B) do{ MF; X[B]=EX(X[B]); X[B+1]=EX(X[B+1]); X[B+2]=EX(X[B+2]); X[B+3]=EX(X[B+3]); PIN(X); SBAR(); }while(0)
  #define VRD(i) do{ vlo[i]=vtr(vp_+(((i)>>2)*4096+((i)&3)*1024)); vhi[i]=vtr(vp_+(((i)>>2)*4096+((i)&3)*1024+512)); }while(0)
  #define GAPB2(MF,X,B) do{ MF; X[B]=EX(X[B]); X[B+1]=EX(X[B+1]); PIN(X); SBAR(); }while(0)
  #define VRD2(i) do{ vlo[i]=vtr(vp_+((2+((i)>>2))*4096+((i)&3)*1024)); vhi[i]=vtr(vp_+((2+((i)>>2))*4096+((i)&3)*1024+512)); SBAR(); }while(0)
  #define KRD(G,j) do{ if(G){ kload2(kf,kp0+sl_next,j); SBAR(); } }while(0)
  #define STEP(C0,C1,P0,P1,t,GK,GV,GL) do{ SBAR(); const float sc_=(kb0+cs*(float)(64*(t)))-mhat; BIN0(C0); SBAR(); \
    const lds_cptr vp_=vp0+2*sl_prev; \
    VRD(0); SBAR(); float sacc=(P0[0]+P0[1]); \
    GAPA(C0=__builtin_amdgcn_mfma_f32_32x32x16_bf16(kf[0],qr[0],C0,0,0,0), P0[2],P0[3],P0[4],P0[5],     pw0[0]=PKW(P0,0), pw0[1]=PKW(P0,2), pw0); \
    VRD(4); SBAR(); BIN1(C1); SBAR(); GAPA(C1=__builtin_amdgcn_mfma_f32_32x32x16_bf16(kf[1],qr[0],C1,0,0,0), P0[6],P0[7],P0[8],P0[9],     pw0[2]=PKW(P0,4), pw0[3]=PKW(P0,6), pw0); \
    VRD(1); SBAR(); GAPA(C0=__builtin_amdgcn_mfma_f32_32x32x16_bf16(kf[2],qr[1],C0,0,0,0),   P0[10],P0[11],P0[12],P0[13], pw1[0]=PKW(P0,8), pw1[1]=PKW(P0,10), pw1); \
    VRD(5); SBAR(); GAPA(C1=__builtin_amdgcn_mfma_f32_32x32x16_bf16(kf[3],qr[1],C1,0,0,0),   P0[14],P0[15],P1[0],P1[1],   pw1[2]=PKW(P0,12),pw1[3]=PKW(P0,14), pw1); \
    VRD(2); SBAR(); GAPA(C0=__builtin_amdgcn_mfma_f32_32x32x16_bf16(kf[4],qr[2],C0,0,0,0),   P1[2],P1[3],P1[4],P1[5],     pw2[0]=PKW(P1,0), pw2[1]=PKW(P1,2), pw2); \
    VRD(6); SBAR(); GAPA(C1=__builtin_amdgcn_mfma_f32_32x32x16_bf16(kf[5],qr[2],C1,0,0,0),   P1[6],P1[7],P1[8],P1[9],     pw2[2]=PKW(P1,4), pw2[3]=PKW(P1,6), pw2); \
    VRD(3); SBAR(); GAPA(C0=__builtin_amdgcn_mfma_f32_32x32x16_bf16(kf[6],qr[3],C0,0,0,0),   P1[10],P1[11],P1[12],P1[13], pw3[0]=PKW(P1,8), pw3[1]=PKW(P1,10), pw3); \
    VRD(7); SBAR(); GAPA(C1=__builtin_amdgcn_mfma_f32_32x32x16_bf16(kf[7],qr[3],C1,0,0,0),   P1[14],P1[15],0.f,0.f,       pw3[2]=PKW(P1,12),pw3[3]=PKW(P1,14), pw3); \
    l_reg+=sacc; \
    if(GK){DMA_K((t)+3,sl_cur);} if(GV){DMA_V((t)+1,sl_next);} \
    CMASK(C0,C1,t); \
    { float a=MX3(C0[0],C0[1],C1[0]),b=MX3(C0[2],C0[3],C1[1]); a=MX3(a,C1[2],C1[3]); \
      _Pragma("unroll") for(int r=4;r<16;r+=4){a=MX3(a,C0[r],C0[r+1]);b=MX3(b,C0[r+2],C0[r+3]);a=MX3(a,C1[r],C1[r+1]);b=MX3(b,C1[r+2],C1[r+3]);} \
      float rm=__builtin_fmaxf(a,b); { auto rr=__builtin_amdgcn_permlane32_swap(__float_as_uint(rm),__float_as_uint(rm),false,false); rm=__builtin_fmaxf(__uint_as_float(rr[0]),__uint_as_float(rr[1])); } \
      resc=false; \
      if(__builtin_expect(__any(rm>(float)THRL),0)){ const float dl=__builtin_fmaxf(rm,0.f); mhat+=dl; \
        _Pragma("unroll") for(int r=0;r<16;++r){C0[r]-=dl;C1[r]-=dl;} \
        const float f=__builtin_amdgcn_exp2f(-dl); l_reg*=f; if(hi==0)wsf[r32]=f; resc=true; } } \
    SBAR(); \
    GAPB2(o[0]=__builtin_amdgcn_mfma_f32_32x32x16_bf16(PAF(0),VFR(0),o[0],0,0,0), C0,0); VRD2(0); \
    GAPB2(o[1]=__builtin_amdgcn_mfma_f32_32x32x16_bf16(PAF(0),VFR(4),o[1],0,0,0), C0,2); VRD2(4); \
    GAPB2(o[0]=__builtin_amdgcn_mfma_f32_32x32x16_bf16(PAF(1),VFR(1),o[0],0,0,0), C0,4); VRD2(1); \
    GAPB2(o[1]=__builtin_amdgcn_mfma_f32_32x32x16_bf16(PAF(1),VFR(5),o[1],0,0,0), C0,6); VRD2(5); \
    GAPB2(o[0]=__builtin_amdgcn_mfma_f32_32x32x16_bf16(PAF(2),VFR(2),o[0],0,0,0), C0,8); VRD2(2); \
    GAPB2(o[1]=__builtin_amdgcn_mfma_f32_32x32x16_bf16(PAF(2),VFR(6),o[1],0,0,0), C0,10); VRD2(6); \
    GAPB2(o[0]=__builtin_amdgcn_mfma_f32_32x32x16_bf16(PAF(3),VFR(3),o[0],0,0,0), C0,12); VRD2(3); \
    GAPB2(o[1]=__builtin_amdgcn_mfma_f32_32x32x16_bf16(PAF(3),VFR(7),o[1],0,0,0), C0,14); VRD2(7); \
    KRD(GL,0); GAPB2(o[2]=__builtin_amdgcn_mfma_f32_32x32x16_bf16(PAF(0),VFR(0),o[2],0,0,0), C1,0); \
    KRD(GL,1); GAPB2(o[3]=__builtin_amdgcn_mfma_f32_32x32x16_bf16(PAF(0),VFR(4),o[3],0,0,0), C1,2); \
    KRD(GL,2); GAPB2(o[2]=__builtin_amdgcn_mfma_f32_32x32x16_bf16(PAF(1),VFR(1),o[2],0,0,0), C1,4); \
    KRD(GL,3); GAPB2(o[3]=__builtin_amdgcn_mfma_f32_32x32x16_bf16(PAF(1),VFR(5),o[3],0,0,0), C1,6); \
    GAPB2(o[2]=__builtin_amdgcn_mfma_f32_32x32x16_bf16(PAF(2),VFR(2),o[2],0,0,0), C1,8); \
    GAPB2(o[3]=__builtin_amdgcn_mfma_f32_32x32x16_bf16(PAF(2),VFR(6),o[3],0,0,0), C1,10); \
    GAPB2(o[2]=__builtin_amdgcn_mfma_f32_32x32x16_bf16(PAF(3),VFR(3),o[2],0,0,0), C1,12); \
    GAPB2(o[3]=__builtin_amdgcn_mfma_f32_32x32x16_bf16(PAF(3),VFR(7),o[3],0,0,0), C1,14); \
    }while(0)
  int t=1;
  #undef CMASK
  #define CMASK(P0,P1,t) do{}while(0)
  for(;t+5<NT;t+=2){
    STEP(pB0,pB1,pA0,pA1,t,true,true,true);     WAIT_BAR(3); RESC(); ROT();
    STEP(pA0,pA1,pB0,pB1,t+1,true,true,true);   WAIT_BAR(3); RESC(); ROT();
  }
  #undef CMASK
  #define CMASK(P0,P1,t) do{int jb_=(t)-(NT-4); if(jb_>=0)cmask(P0,P1,jb_,qrel,hi);}while(0)
  #define ENDW(tt) do{ if((tt)+3<NT){WAIT_BAR(3);} else if((tt)+2<NT){WAIT_BAR(2);} else {WAIT_BAR(0);} }while(0)
  for(;t+1<NT;t+=2){
    STEP(pB0,pB1,pA0,pA1,t,(t+3<NT),(t+1<NT),(t+1<NT));       ENDW(t);   RESC(); ROT();
    STEP(pA0,pA1,pB0,pB1,t+1,(t+4<NT),(t+2<NT),(t+2<NT));     ENDW(t+1); RESC(); ROT();
  }
  STEP(pB0,pB1,pA0,pA1,NT-1,false,false,false); RESC();
  { float sacc=pB0[0]+pB0[1]; _Pragma("unroll") for(int r=2;r<16;++r)sacc+=pB0[r]; _Pragma("unroll") for(int r=0;r<16;++r)sacc+=pB1[r]; l_reg+=sacc;
    pw0=(u32x4){PKW(pB0,0),PKW(pB0,2),PKW(pB0,4),PKW(pB0,6)};pw1=(u32x4){PKW(pB0,8),PKW(pB0,10),PKW(pB0,12),PKW(pB0,14)};pw2=(u32x4){PKW(pB1,0),PKW(pB1,2),PKW(pB1,4),PKW(pB1,6)};pw3=(u32x4){PKW(pB1,8),PKW(pB1,10),PKW(pB1,12),PKW(pB1,14)};
    SBAR(); pv(o,vb0+2*sl_cur,PAF(0),PAF(1),PAF(2),PAF(3)); }
  #undef PKW
  #undef PAF
  #undef VFR
  #undef PIN
  #undef MX3
  #undef GAPA
  #undef GAPB
  #undef GAPB2
  #undef VRD2
  #undef EX
  #undef VRD
  #undef KRD
  #undef STEP
  #undef ENDW
  {auto rr=__builtin_amdgcn_permlane32_swap(__float_as_uint(l_reg),__float_as_uint(l_reg),false,false);l_reg=__uint_as_float(rr[0])+__uint_as_float(rr[1]);}
  if(hi==0)wsf[32+r32]=l_reg;asm volatile("s_waitcnt lgkmcnt(0)":::"memory");
  float rli[16];
  #pragma unroll
  for(int r=0;r<16;++r)rli[r]=__builtin_amdgcn_rcpf(wsf[32+crow(r,hi)]);
  { typedef __attribute__((address_space(1))) unsigned short gbf16; gbf16*Dw=(gbf16*)Dg+(rowbase+q0+wid*QBLK+4*hi)*768+r32; asm volatile("":"+v"(Dw));
    #pragma unroll
    for(int r=0;r<16;++r){
      #pragma unroll
      for(int d0=0;d0<4;++d0){ gbf16*p=Dw+((r&3)+8*(r>>2))*768+d0*32; const float v_=o[d0][r]*rli[r]; *p=(unsigned short)cvtpk_s(v_,v_); } } }
  asm volatile("s_waitcnt lgkmcnt(0)\n\ts_barrier":::"memory");
  #undef DMA_K
  #undef DMA_V
  #undef CMASK
  #undef START
  #undef RESC
  #undef ROT
  #undef BIN0
  #undef BIN1
}
constexpr int ATTN_LDS_BYTES=LDS_BYTES;
#undef SBAR
#undef WAIT_BAR
}

namespace cg = cooperative_groups;
#ifndef MK_ONE_LAUNCH
#define MK_ONE_LAUNCH 1
#endif
constexpr int NWAVES = 8, NTHR = 512;
constexpr int BATCH = 2, SEQ = 8192, DM = 2048, M = BATCH * SEQ, DEPTH = 4, INW = 6400, FFH = 5632, NGU = 2 * FFH;
constexpr int C_RQ = 0, C_RK = 768, C_RV = 1536, C_RG = 2304, C_DQ = 3072, C_DK = 3840, C_DV = 4608, C_SU = 5376, C_SV = 5888;
constexpr float EPS = 1e-6f, LOG2E = 1.4426950408889634f;
constexpr size_t MiB = 1u << 20;
constexpr size_t WS_CTL = 0, CTL_ZERO_BYTES = 65536, WS_SGUW = 1 * MiB, WS_RS = 1 * MiB + 768 * 1024, WS_WIN = 2 * MiB, WS_WOUT = 102 * MiB, WS_WGU = 134 * MiB, WS_WDN = 310 * MiB, WS_XN = 398 * MiB,
                 WS_PROJ = 462 * MiB, WS_HID = 462 * MiB, WS_CAT = 662 * MiB, WS_F32 = 726 * MiB, WS_DIFF = 726 * MiB, WS_KVT = 774 * MiB, WS_RT = 822 * MiB, WS_DIFF1 = 854 * MiB, WS_END = 902 * MiB;
constexpr int CW_QUEUE = 64;
constexpr int CW_BAR = 8192;
constexpr int TS = 136, TILE_B = 128 * TS * 2;
constexpr int RING_BYTES = 4 * TILE_B;
constexpr int MISC_OFF = RING_BYTES, LDS_BYTES = 147456;
static_assert(pg8::STAGE_BYTES <= RING_BYTES && attn_body::LDS_WS + 2048 <= RING_BYTES && MISC_OFF + 256 <= LDS_BYTES, "LDS map");

#define GAS __attribute__((address_space(1)))
#define LAS __attribute__((address_space(3)))
typedef unsigned short bfu;
typedef unsigned v4u __attribute__((ext_vector_type(4)));
typedef unsigned v2u __attribute__((ext_vector_type(2)));
typedef float f32x4 __attribute__((ext_vector_type(4)));
typedef short bf16x8 __attribute__((ext_vector_type(8)));
#define LDS_WAIT() asm volatile("s_waitcnt lgkmcnt(0)" ::: "memory")
__device__ __forceinline__ unsigned f2bf(float f) { unsigned u = __builtin_bit_cast(unsigned, f); return (u + 0x7fffu + ((u >> 16) & 1u)) >> 16; }
__device__ __forceinline__ unsigned pk2(float lo, float hi) { return pg8::cvt_pk_bf16(lo, hi); }
__device__ __forceinline__ float bflo(unsigned w) { return __builtin_bit_cast(float, w << 16); }
__device__ __forceinline__ float bfhi(unsigned w) { return __builtin_bit_cast(float, w & 0xffff0000u); }
__device__ __forceinline__ float wave_sum(float v) {
#pragma unroll
    for (int o = 1; o < 64; o <<= 1) v += __shfl_xor(v, o);
    return v;
}
__device__ __forceinline__ float fexp2(float x) { return __builtin_amdgcn_exp2f(x); }
__device__ __forceinline__ float frcp(float x) { return __builtin_amdgcn_rcpf(x); }
__device__ __forceinline__ float silu_f(float g) { return g * frcp(1.f + fexp2(-LOG2E * g)); }
__device__ __forceinline__ float gelu_tanh(float x) { const float z = 0.7978845608028654f * (x + 0.044715f * x * x * x); return x * frcp(1.f + fexp2(-2.f * LOG2E * z)); }
__device__ __forceinline__ float ret_log2gamma(int h) { return log2f(1.f - exp2f(-5.f - (float)h)); }

#define XB_TMO      128
#define XB_XCNT(j)  (256  + 64 * (j))
#define XB_XSUB(j)  (1280 + 64 * (j))
#define XB_XGEN(j)  (2304 + 64 * (j))
#define XB_TOP      3328
#define XB_TOPGEN   3392
#define XCD_BAR_WORDS 3456
#define XB_SPIN_CAP (1u << 18)

__device__ __forceinline__ unsigned xb_ld(unsigned* p)              { return __hip_atomic_load(p, __ATOMIC_RELAXED, __HIP_MEMORY_SCOPE_AGENT); }
__device__ __forceinline__ unsigned xb_add(unsigned* p, unsigned v) { return __hip_atomic_fetch_add(p, v, __ATOMIC_RELAXED, __HIP_MEMORY_SCOPE_AGENT); }
__device__ __forceinline__ unsigned xb_xcc_id() { return (unsigned)__builtin_amdgcn_s_getreg((3 << 11) | 20) & 0xFu; }
#define XB_SPIN(cond, bar) do { unsigned _sp = 0; while (cond) { __builtin_amdgcn_s_sleep(1); \
    if ((++_sp & 255u) == 0u) { if (xb_ld(&(bar)[XB_TMO])) break; if (_sp > XB_SPIN_CAP) { atomicAdd(&(bar)[XB_TMO], 1u); break; } } } } while (0)

struct XcdBarrier {
    unsigned* bar; unsigned x;
    volatile LAS unsigned* st;
};

__device__ __forceinline__ XcdBarrier xcd_barrier_post(unsigned* bar, volatile LAS unsigned* st) {
    XcdBarrier b; b.bar = bar; b.x = xb_xcc_id(); b.st = st;
    if (threadIdx.x == 0) (void)xb_add(&bar[XB_XCNT(b.x)], 1u);
    return b;
}
__device__ __forceinline__ void xcd_barrier_complete(unsigned* bar, unsigned x, unsigned& nloc, unsigned& nx) {
    const unsigned G = gridDim.x * gridDim.y * gridDim.z;
    unsigned sum, cnt, mine, sp = 0u;
    for (;;) {
        sum = 0u; cnt = 0u; mine = 0u;
#pragma unroll
        for (unsigned j = 0; j < 16; ++j) { const unsigned c = xb_ld(&bar[XB_XCNT(j)]); sum += c; cnt += (c > 0u) ? 1u : 0u; mine = (j == x) ? c : mine; }
        if (sum == G) break;
        __builtin_amdgcn_s_sleep(1);
        if ((++sp & 255u) == 0u) { if (xb_ld(&bar[XB_TMO])) break; if (sp > XB_SPIN_CAP) { atomicAdd(&bar[XB_TMO], 1u); break; } }
    }
    nloc = mine > 0u ? mine : 1u; nx = cnt > 0u ? cnt : 1u;
}

__device__ __forceinline__ void xcd_barrier(const XcdBarrier& b) {
    asm volatile("s_waitcnt vmcnt(0)" ::: "memory");
    __syncthreads();
    if (threadIdx.x == 0) {
        unsigned* bar = b.bar;
        __builtin_amdgcn_s_waitcnt(0);
        unsigned nloc = b.st[0], nx = b.st[1];
        if (nloc == 0u) { xcd_barrier_complete(bar, b.x, nloc, nx); b.st[0] = nloc; b.st[1] = nx; }
        const unsigned old = xb_add(&bar[XB_XSUB(b.x)], 1u);
        const unsigned gen = old / nloc;
        if (old + 1u == (gen + 1u) * nloc) {
            __builtin_amdgcn_fence(__ATOMIC_RELEASE, "agent");
            asm volatile("s_waitcnt vmcnt(0)" ::: "memory");
            const unsigned og = xb_add(&bar[XB_TOP], 1u);
            const unsigned tg = og / nx;
            if (og + 1u == (tg + 1u) * nx) xb_add(&bar[XB_TOPGEN], 1u);
            else XB_SPIN(xb_ld(&bar[XB_TOPGEN]) == tg, bar);
            __builtin_amdgcn_fence(__ATOMIC_ACQUIRE, "agent");
            xb_add(&bar[XB_XGEN(b.x)], 1u);
            asm volatile("s_waitcnt vmcnt(0)" ::: "memory");
        } else {
            XB_SPIN(xb_ld(&bar[XB_XGEN(b.x)]) == gen, bar);
            __builtin_amdgcn_fence(__ATOMIC_ACQUIRE, "agent");
            asm volatile("s_waitcnt vmcnt(0)" ::: "memory");
        }
    }
    __syncthreads();
}

struct Args { const float* in[20]; float* out; unsigned char* ws; int ph_lo, ph_hi; };
__device__ __forceinline__ const float* karg(int k) { int kk = k; asm volatile("" : "+s"(kk)); return ((const float* const __attribute__((address_space(4)))*)__builtin_amdgcn_kernarg_segment_ptr())[kk]; }

__device__ __forceinline__ void p0_transpose_item(const float* W, int K, int N, bfu* WT, int drow0, LAS float* scr, int k0, int n0, int lane, const float* gk) {
#pragma unroll 8
    for (int i = 0; i < 32; ++i) { const int kk = 2 * i + (lane >> 5); scr[kk * 33 + (lane & 31)] = W[(size_t)(k0 + kk) * N + n0 + (lane & 31)]; }
    LDS_WAIT(); asm volatile("" ::: "memory");
    const int c = lane & 7;
    f32x4 ga = (f32x4){1.f, 1.f, 1.f, 1.f}, gb = ga;
    if (gk) { ga = *(const f32x4*)(gk + k0 + 8 * c); gb = *(const f32x4*)(gk + k0 + 8 * c + 4); }
#pragma unroll
    for (int j = 0; j < 4; ++j) { const int n = (lane >> 3) + 8 * j; const LAS float* s = scr + (8 * c) * 33 + n;
        v4u o; o.x = pk2(s[0 * 33] * ga.x, s[1 * 33] * ga.y); o.y = pk2(s[2 * 33] * ga.z, s[3 * 33] * ga.w); o.z = pk2(s[4 * 33] * gb.x, s[5 * 33] * gb.y); o.w = pk2(s[6 * 33] * gb.z, s[7 * 33] * gb.w);
        *(v4u*)(WT + (size_t)(drow0 + n) * K + k0 + 8 * c) = o; }
    LDS_WAIT(); asm volatile("" ::: "memory");
}
__device__ __forceinline__ void xn_rows(const float* x, bfu* XB, float* RS, int gw, int NGW, int lane) {
    for (int m = gw; m < M; m += NGW) {
        const f32x4* xr = (const f32x4*)(x + (size_t)m * DM) + lane; f32x4 v[8]; float s = 0.f;
#pragma unroll
        for (int j = 0; j < 8; ++j) { v[j] = xr[64 * j]; s += (v[j].x * v[j].x + v[j].y * v[j].y) + (v[j].z * v[j].z + v[j].w * v[j].w); }
        const float rstd = 1.f / sqrtf(wave_sum(s) * (1.f / DM) + EPS);
        v2u* o8 = (v2u*)(XB + (size_t)m * DM) + lane;
#pragma unroll
        for (int j = 0; j < 8; ++j) { v2u w; w.x = pk2(v[j].x, v[j].y); w.y = pk2(v[j].z, v[j].w); o8[64 * j] = w; }
        if (lane == 0) RS[m] = rstd;
    }
}
template <bool FINAL, bool DUMMY = false> __device__ __forceinline__ void norm_rows(const bfu* F, bfu* XB, const float* g1, float* RS, float* xout, int gw, int NGW, int lane, bfu* dummy = nullptr) {
    int m = gw; if (m >= M) return;
    v2u fw[8], xw[8];
#pragma unroll
    for (int j = 0; j < 8; ++j) { fw[j] = ((const v2u*)(F + (size_t)m * DM) + lane)[64 * j]; xw[j] = ((const v2u*)(XB + (size_t)m * DM) + lane)[64 * j]; }
    for (; m < M; m += NGW) {
        f32x4 f[8], x[8]; float s = 0.f;
#pragma unroll
        for (int j = 0; j < 8; ++j) { f[j] = (f32x4){bflo(fw[j].x), bfhi(fw[j].x), bflo(fw[j].y), bfhi(fw[j].y)}; x[j] = (f32x4){bflo(xw[j].x), bfhi(xw[j].x), bflo(xw[j].y), bfhi(xw[j].y)}; }
        const int mn = m + NGW;
        if (mn < M) {
#pragma unroll
            for (int j = 0; j < 8; ++j) { fw[j] = ((const v2u*)(F + (size_t)mn * DM) + lane)[64 * j]; xw[j] = ((const v2u*)(XB + (size_t)mn * DM) + lane)[64 * j]; }
        }
#pragma unroll
        for (int j = 0; j < 8; ++j) s += (f[j].x * f[j].x + f[j].y * f[j].y) + (f[j].z * f[j].z + f[j].w * f[j].w);
        const float rstd1 = 1.f / sqrtf(wave_sum(s) * (1.f / DM) + EPS);
        float s2 = 0.f;
#pragma unroll
        for (int j = 0; j < 8; ++j) { const f32x4 gg = ((const f32x4*)g1)[lane + 64 * j]; x[j] = x[j] + f[j] * rstd1 * gg; s2 += (x[j].x * x[j].x + x[j].y * x[j].y) + (x[j].z * x[j].z + x[j].w * x[j].w); }
        if (FINAL) { f32x4* xo = (f32x4*)(xout + (size_t)m * DM) + lane;
#pragma unroll
            for (int j = 0; j < 8; ++j) xo[64 * j] = x[j];
        } else {
            v2u* xr = (v2u*)((DUMMY ? dummy : XB) + (size_t)m * DM) + lane;
#pragma unroll
            for (int j = 0; j < 8; ++j) { v2u w; w.x = pk2(x[j].x, x[j].y); w.y = pk2(x[j].z, x[j].w); xr[64 * j] = w; }
            const float rstd2 = 1.f / sqrtf(wave_sum(s2) * (1.f / DM) + EPS);
            if (lane == 0) (DUMMY ? (float*)dummy + (size_t)M * DM : RS)[m] = rstd2;
        }
    }
}

__device__ __forceinline__ void stage_nat(LAS bfu* dst, const bfu* src, int pitch, int tid) {
#pragma unroll
    for (int i = 0; i < 4; ++i) { const int id = tid + NTHR * i, r = id >> 4, ch = id & 15; const v4u v = *(const v4u*)(src + (size_t)r * pitch + ch * 8); *(LAS v4u*)(dst + r * TS + ch * 8) = v; }
}
template <bool SC> __device__ __forceinline__ void stage_tr(LAS bfu* dst, const bfu* src, int pitch, int tid, float lg) {
#pragma unroll
    for (int i = 0; i < 4; ++i) { const int id = tid + NTHR * i, c = id & 127, ch = id >> 7; const v4u v = *(const v4u*)(src + (size_t)c * pitch + ch * 8);
        const float sc = SC ? fexp2(lg * (float)(127 - c)) : 1.f;
#pragma unroll
        for (int j = 0; j < 4; ++j) { unsigned w = v[j];
            if (SC) w = pk2(bflo(w) * sc, bfhi(w) * sc);
            dst[(ch * 8 + 2 * j) * TS + c] = (bfu)(w & 0xffffu); dst[(ch * 8 + 2 * j + 1) * TS + c] = (bfu)(w >> 16); } }
}
__device__ __forceinline__ void wave_mma(f32x4 (&acc)[8], const LAS bfu* As, const LAS bfu* Bs, int m0, int fr, int fq) {
#pragma unroll
    for (int ks = 0; ks < 4; ++ks) { const bf16x8 a = *(const LAS bf16x8*)(As + (m0 + fr) * TS + ks * 32 + fq * 8);
#pragma unroll
        for (int t = 0; t < 8; ++t) { const bf16x8 b = *(const LAS bf16x8*)(Bs + (t * 16 + fr) * TS + ks * 32 + fq * 8); acc[t] = __builtin_amdgcn_mfma_f32_16x16x32_bf16(b, a, acc[t], 0, 0, 0); } }
}
#define ZERO8(a) do { _Pragma("unroll") for (int t_ = 0; t_ < 8; ++t_) a[t_] = (f32x4){0.f, 0.f, 0.f, 0.f}; } while (0)

#ifndef PG8ALIGN
#define PG8ALIGN true
#endif
#ifndef PG8SP2
#define PG8SP2 true
#endif
#ifndef XSKIP
#define XSKIP 1
#endif
#ifndef XTAIL
#define XTAIL 0
#endif
#ifndef ATT_THRL
#define ATT_THRL 80
#endif
constexpr int Q_SCAN = 768, Q_ATT = Q_SCAN + 96, Q_RET = Q_ATT + 768, Q_SGU = Q_RET + 768, Q_END = Q_SGU + 512;
__device__ __forceinline__ void st_sc1_u2(void* p, unsigned lo, unsigned hi) { __hip_atomic_store((GAS unsigned long long*)p, ((unsigned long long)hi << 32) | (unsigned long long)lo, __ATOMIC_RELAXED, __HIP_MEMORY_SCOPE_AGENT); }
__device__ __forceinline__ void st_sc1_x4(float* p, f32x4 v) { st_sc1_u2(p, __float_as_uint(v[0]), __float_as_uint(v[1])); st_sc1_u2(p + 2, __float_as_uint(v[2]), __float_as_uint(v[3])); }
__device__ __forceinline__ void publish(unsigned* word) {
    asm volatile("s_waitcnt vmcnt(0)" ::: "memory"); __syncthreads();
    if (threadIdx.x == 0) __hip_atomic_fetch_add(word, 1u, __ATOMIC_RELAXED, __HIP_MEMORY_SCOPE_AGENT);
}
__device__ __forceinline__ void publish_release(unsigned* word) {
    asm volatile("s_waitcnt vmcnt(0)" ::: "memory"); __syncthreads();
    if (threadIdx.x == 0) { __builtin_amdgcn_fence(__ATOMIC_RELEASE, "agent"); asm volatile("s_waitcnt vmcnt(0)" ::: "memory"); __hip_atomic_fetch_add(word, 1u, __ATOMIC_RELAXED, __HIP_MEMORY_SCOPE_AGENT); }
}
__device__ __forceinline__ void wait_ge(unsigned* word, unsigned want, unsigned* tmo) {
    if (threadIdx.x == 0) {
        unsigned sp = 0;
        while (__hip_atomic_load(word, __ATOMIC_RELAXED, __HIP_MEMORY_SCOPE_AGENT) < want) {
            __builtin_amdgcn_s_sleep(2);
            if (++sp > (1u << 21)) { __hip_atomic_store(tmo, 1u, __ATOMIC_RELAXED, __HIP_MEMORY_SCOPE_AGENT); break; }
            if ((sp & 1023u) == 0u && __hip_atomic_load(tmo, __ATOMIC_RELAXED, __HIP_MEMORY_SCOPE_AGENT)) break;
        }
        __builtin_amdgcn_fence(__ATOMIC_ACQUIRE, "agent");
        asm volatile("s_waitcnt vmcnt(0)" ::: "memory");
    }
    __syncthreads();
}
__device__ __forceinline__ void qk_norms(LAS unsigned char* lds, const bfu* PROJ, unsigned* nw) {
    int tid = threadIdx.x; asm volatile("" : "+v"(tid)); const int lane = tid & 63, wid = __builtin_amdgcn_readfirstlane(tid >> 6);
    const int gw = blockIdx.x * NWAVES + wid, NGW = gridDim.x * NWAVES;
    float m0[3] = {0.f, 0.f, 0.f}, m1[3] = {0.f, 0.f, 0.f};
    for (int mb = gw; mb < M; mb += 4 * NGW) {
        v4u w[4][3];
#pragma unroll
        for (int r = 0; r < 4; ++r) { const int m = mb + r * NGW; const bfu* rp = PROJ + (size_t)(m < M ? m : mb) * INW + C_DQ + lane * 8;
#pragma unroll
            for (int ld = 0; ld < 3; ++ld) w[r][ld] = *(const v4u*)(rp + ld * 512); }
#pragma unroll
        for (int r = 0; r < 4; ++r) { const int m = mb + r * NGW; if (m >= M) break; float s[3];
#pragma unroll
            for (int ld = 0; ld < 3; ++ld) { float a = 0.f;
#pragma unroll
                for (int j = 0; j < 4; ++j) { const float lo = bflo(w[r][ld][j]), hi = bfhi(w[r][ld][j]); a += lo * lo + hi * hi; }
                a += __shfl_xor(a, 1); a += __shfl_xor(a, 2); a += __shfl_xor(a, 4); s[ld] = a; }
            if (m >= SEQ) { m1[0] = fmaxf(m1[0], s[0]); m1[1] = fmaxf(m1[1], s[1]); m1[2] = fmaxf(m1[2], s[2]); }
            else          { m0[0] = fmaxf(m0[0], s[0]); m0[1] = fmaxf(m0[1], s[1]); m0[2] = fmaxf(m0[2], s[2]); } }
    }
    LAS float* red = (LAS float*)lds;
    if ((lane & 7) == 0) {
#pragma unroll
        for (int ld = 0; ld < 3; ++ld) { red[wid * 48 + ld * 8 + (lane >> 3)] = m0[ld]; red[wid * 48 + 24 + ld * 8 + (lane >> 3)] = m1[ld]; } }
    __syncthreads();
    if (tid < 48) { float v = red[tid];
#pragma unroll
        for (int w = 1; w < 8; ++w) v = fmaxf(v, red[w * 48 + tid]);
        const unsigned old = __hip_atomic_fetch_max(nw + tid, __float_as_uint(v), __ATOMIC_RELAXED, __HIP_MEMORY_SCOPE_AGENT); asm volatile("" :: "v"(old)); }
}
struct AttnOrder { unsigned char u[2][96]; };
constexpr AttnOrder make_attn_order() {
    AttnOrder o{}; const int win[6] = {12, 20, 40, 96, 999, 999}; const int hd[2][3] = {{0, 3, 5}, {1, 2, 4}};
    for (int ty = 0; ty < 2; ++ty) { int cost[96] = {}; int id[96] = {}; int n = 0;
        for (int qb = 31; qb >= 0; --qb) for (int sl = 0; sl < 3; ++sl) { const int w = win[hd[ty][sl]], c = (4 * qb + 4 < w) ? 4 * qb + 4 : w; cost[n] = c; id[n] = (sl << 5) | qb; ++n; }
        for (int i = 1; i < 96; ++i) { const int c = cost[i], v = id[i]; int j = i - 1; while (j >= 0 && cost[j] < c) { cost[j + 1] = cost[j]; id[j + 1] = id[j]; --j; } cost[j + 1] = c; id[j + 1] = v; }
        for (int i = 0; i < 96; ++i) o.u[ty][i] = (unsigned char)id[i]; }
    return o;
}
__device__ const AttnOrder ATTN_ORDER = make_attn_order();
__device__ __forceinline__ void kv_unit(LAS unsigned char* lds, const bfu* PROJ, float* KVT, int u) {
    int tid = threadIdx.x; asm volatile("" : "+v"(tid)); const int lane = tid & 63, wid = __builtin_amdgcn_readfirstlane(tid >> 6); (void)lane; (void)wid;
    const int bh = u >> 6, i = u & 63, b = bh / 6, h = bh % 6; const size_t row0 = (size_t)b * SEQ + (size_t)i * 128; const float lg = ret_log2gamma(h);
    LAS bfu* Vt = (LAS bfu*)lds; LAS bfu* Kt = (LAS bfu*)(lds + TILE_B);
    stage_tr<false>(Vt, PROJ + row0 * INW + C_RV + h * 128, INW, tid, 0.f);
    stage_tr<true>(Kt, PROJ + row0 * INW + C_RK + h * 128, INW, tid, lg);
    __syncthreads();
    const int fr = lane & 15, fq = lane >> 4, m0 = wid * 16; f32x4 acc[8]; ZERO8(acc);
    wave_mma(acc, Vt, Kt, m0, fr, fq);
    float* o = KVT + (size_t)u * 16384 + (m0 + fr) * 128 + 4 * fq;
#pragma unroll
    for (int t = 0; t < 8; ++t) st_sc1_x4(o + 16 * t, acc[t]);
}
__device__ __forceinline__ void scan_unit(const float* KVT, bfu* RT, int s) {
    int tid = threadIdx.x; asm volatile("" : "+v"(tid)); const int lane = tid & 63, wid = __builtin_amdgcn_readfirstlane(tid >> 6); (void)lane; (void)wid;
    const int bh = s >> 3, part = s & 7, h = bh % 6; const float G = exp2f(ret_log2gamma(h) * 128.f);
    const size_t e = (size_t)bh * 64 * 16384 + part * 2048 + tid * 4; f32x4 st = (f32x4){0.f, 0.f, 0.f, 0.f};
#pragma unroll 8
    for (int i = 0; i < 64; ++i) { const f32x4 cur = *(const f32x4*)(KVT + e + (size_t)i * 16384); st_sc1_u2(RT + e + (size_t)i * 16384, pk2(st[0], st[1]), pk2(st[2], st[3])); st = cur + st * G; }
}
__device__ __forceinline__ void ret_unit(LAS unsigned char* lds, const bfu* PROJ, const bfu* RT, const float* gn_g, bfu* CAT, int u) {
    int tid = threadIdx.x; asm volatile("" : "+v"(tid)); const int lane = tid & 63, wid = __builtin_amdgcn_readfirstlane(tid >> 6); (void)lane; (void)wid;
    const int bh = u >> 6, i = u & 63, b = bh / 6, h = bh % 6; const size_t row0 = (size_t)b * SEQ + (size_t)i * 128; const float lg = ret_log2gamma(h);
    LAS bfu* Qs = (LAS bfu*)lds; LAS bfu* Ks = (LAS bfu*)(lds + TILE_B); LAS bfu* Vt = (LAS bfu*)(lds + 2 * TILE_B); LAS bfu* Rt = (LAS bfu*)(lds + 3 * TILE_B);
    const bfu* P0 = PROJ + row0 * INW + h * 128;
    stage_nat(Qs, P0 + C_RQ, INW, tid); stage_nat(Ks, P0 + C_RK, INW, tid); stage_tr<false>(Vt, P0 + C_RV, INW, tid, 0.f); stage_nat(Rt, RT + (size_t)u * 16384, 128, tid);
    __syncthreads();
    const int fr = lane & 15, fq = lane >> 4, m0 = wid * 16, c = m0 + fr;
    f32x4 acc[8], cr[8]; ZERO8(acc); ZERO8(cr);
    wave_mma(cr, Qs, Rt, m0, fr, fq);
    wave_mma(acc, Qs, Ks, m0, fr, fq);
    __syncthreads();
#pragma unroll
    for (int t = 0; t < 8; ++t) { float p[4];
#pragma unroll
        for (int j = 0; j < 4; ++j) { const int e = 16 * t + 4 * fq + j; p[j] = (c >= e) ? acc[t][j] * fexp2(lg * (float)(c - e)) : 0.f; }
        v2u w; w.x = pk2(p[0], p[1]); w.y = pk2(p[2], p[3]); *(LAS v2u*)(Ks + c * TS + 16 * t + 4 * fq) = w; }
    LDS_WAIT(); asm volatile("" ::: "memory");
    ZERO8(acc);
    wave_mma(acc, Ks, Vt, m0, fr, fq);
    const float xi = fexp2(lg * (float)(c + 1)); float s = 0.f;
#pragma unroll
    for (int t = 0; t < 8; ++t) { acc[t] = acc[t] + cr[t] * xi; s += (acc[t][0] + acc[t][1]) + (acc[t][2] + acc[t][3]); }
    s += __shfl_xor(s, 16); s += __shfl_xor(s, 32); const float mu = s * (1.f / 128.f); float q = 0.f;
#pragma unroll
    for (int t = 0; t < 8; ++t) { acc[t] = acc[t] - mu; q += (acc[t][0] * acc[t][0] + acc[t][1] * acc[t][1]) + (acc[t][2] * acc[t][2] + acc[t][3] * acc[t][3]); }
    q += __shfl_xor(q, 16); q += __shfl_xor(q, 32); const float rstd = 1.f / sqrtf(q * (1.f / 128.f) + EPS);
    const bfu* gp = P0 + (size_t)c * INW + C_RG + 4 * fq; bfu* op = CAT + (row0 + c) * DM + h * 128 + 4 * fq; const float* gg = gn_g + h * 128 + 4 * fq;
#pragma unroll
    for (int t = 0; t < 8; ++t) { const v2u gw = *(const v2u*)(gp + 16 * t); const f32x4 g4 = *(const f32x4*)(gg + 16 * t);
        const float o0 = silu_f(bflo(gw.x)) * acc[t][0] * rstd * g4.x, o1 = silu_f(bfhi(gw.x)) * acc[t][1] * rstd * g4.y, o2 = silu_f(bflo(gw.y)) * acc[t][2] * rstd * g4.z, o3 = silu_f(bfhi(gw.y)) * acc[t][3] * rstd * g4.w;
        v2u w; w.x = pk2(o0, o1); w.y = pk2(o2, o3); *(v2u*)(op + 16 * t) = w; }
    __syncthreads();
}
__device__ __forceinline__ void sgu_unit(LAS unsigned char* lds, const bfu* PROJ, const bfu* SW  , const float* ln_g, const float* ln_b, const float* sb, bfu* CAT, int s) {
    int tid = threadIdx.x; asm volatile("" : "+v"(tid)); const int lane = tid & 63, wid = __builtin_amdgcn_readfirstlane(tid >> 6); (void)lane; (void)wid;
    const int chunk = s >> 2, g = s & 3; const size_t row0 = (size_t)chunk * 128;
    LAS bfu* Ws = (LAS bfu*)lds; LAS bfu* Vt = (LAS bfu*)(lds + TILE_B); LAS float* red = (LAS float*)(lds + 2 * TILE_B);
    stage_nat(Ws, SW + (size_t)g * 16384, 128, tid);
    const int sr = tid & 127, qd = tid >> 7;
    const bfu* vp = PROJ + (row0 + sr) * INW + C_SV + g * 128 + qd * 32; float v[32]; float a = 0.f, a2 = 0.f;
#pragma unroll
    for (int k = 0; k < 4; ++k) { const v4u w = *(const v4u*)(vp + 8 * k);
#pragma unroll
        for (int j = 0; j < 4; ++j) { const float x0 = gelu_tanh(bflo(w[j])), x1 = gelu_tanh(bfhi(w[j])); v[8 * k + 2 * j] = x0; v[8 * k + 2 * j + 1] = x1; a += x0 + x1; a2 += x0 * x0 + x1 * x1; } }
    red[qd * 128 + sr] = a; red[512 + qd * 128 + sr] = a2;
    __syncthreads();
    { const float sm = (red[sr] + red[128 + sr]) + (red[256 + sr] + red[384 + sr]), sq = (red[512 + sr] + red[640 + sr]) + (red[768 + sr] + red[896 + sr]);
      const float mu = sm * (1.f / 128.f), var = fmaxf(sq * (1.f / 128.f) - mu * mu, 0.f), rstd = 1.f / sqrtf(var + EPS);
      const float* lg_ = ln_g + g * 128 + qd * 32; const float* lb_ = ln_b + g * 128 + qd * 32;
#pragma unroll
      for (int k = 0; k < 32; ++k) Vt[(qd * 32 + k) * TS + sr] = (bfu)f2bf((v[k] - mu) * rstd * lg_[k] + lb_[k]); }
    __syncthreads();
    const int fr = lane & 15, fq = lane >> 4, m0 = wid * 16, t_ = m0 + fr; f32x4 acc[8]; ZERO8(acc);
    wave_mma(acc, Ws, Vt, m0, fr, fq);
    const float bias = sb[g * 128 + t_];
    const bfu* up = PROJ + (row0 + t_) * INW + C_SU + g * 128 + 4 * fq; bfu* op = CAT + (row0 + t_) * DM + 1536 + g * 128 + 4 * fq;
#pragma unroll
    for (int t = 0; t < 8; ++t) { const v2u uw = *(const v2u*)(up + 16 * t);
        v2u w; w.x = pk2(gelu_tanh(bflo(uw.x)) * (acc[t][0] + bias), gelu_tanh(bfhi(uw.x)) * (acc[t][1] + bias)); w.y = pk2(gelu_tanh(bflo(uw.y)) * (acc[t][2] + bias), gelu_tanh(bfhi(uw.y)) * (acc[t][3] + bias));
        *(v2u*)(op + 16 * t) = w; }
    __syncthreads();
}
__device__ __forceinline__ void diff_final(const bfu* D0, const bfu* D1, float lam, const float* sg, float omli, bfu* CAT, int gw, int NGW, int lane) {
    const int half = lane >> 5, l32 = lane & 31;
    for (int it = gw * 2 + half; it < M * 6; it += NGW * 2) { const int row = it / 6, h = it - row * 6;
        const v2u a_ = *(const v2u*)(D0 + (size_t)row * 768 + h * 128 + l32 * 4), b_ = *(const v2u*)(D1 + (size_t)row * 768 + h * 128 + l32 * 4);
        const f32x4 v = (f32x4){bflo(a_.x), bfhi(a_.x), bflo(a_.y), bfhi(a_.y)} - (f32x4){bflo(b_.x), bfhi(b_.x), bflo(b_.y), bfhi(b_.y)} * lam; float s = (v.x * v.x + v.y * v.y) + (v.z * v.z + v.w * v.w);
#pragma unroll
        for (int o = 1; o < 32; o <<= 1) s += __shfl_xor(s, o);
        const float r = omli / sqrtf(s * (1.f / 128.f) + EPS); const f32x4 g4 = *(const f32x4*)(sg + h * 128 + l32 * 4);
        v2u w; w.x = pk2(v.x * r * g4.x, v.y * r * g4.y); w.y = pk2(v.z * r * g4.z, v.w * r * g4.w); *(v2u*)(CAT + (size_t)row * DM + 768 + h * 128 + l32 * 4) = w; }
}

__global__ void __launch_bounds__(NTHR, 2) fwd(Args args) {
    extern __shared__ __attribute__((aligned(16))) unsigned char lds_raw[];
    LAS unsigned char* lds = (LAS unsigned char*)lds_raw;
    volatile LAS int* MISC = (volatile LAS int*)(lds + MISC_OFF);
    const int G = gridDim.x, NGW = G * NWAVES;
#define PIN_TID() int tid = threadIdx.x; asm volatile("" : "+v"(tid)); const int lane = tid & 63, wid = __builtin_amdgcn_readfirstlane(tid >> 6), gw = blockIdx.x * NWAVES + wid; (void)lane; (void)gw
#define WSB ((unsigned char*)karg(21))
#define ctl ((unsigned*)(WSB + WS_CTL))
#define SGUW ((bfu*)(WSB + WS_SGUW))
#define WIN ((bfu*)(WSB + WS_WIN))
#define WOUT ((bfu*)(WSB + WS_WOUT))
#define WGU ((bfu*)(WSB + WS_WGU))
#define WDN ((bfu*)(WSB + WS_WDN))
#define XN ((bfu*)(WSB + WS_XN))
#define PROJ ((bfu*)(WSB + WS_PROJ))
#define HID ((bfu*)(WSB + WS_HID))
#define CAT ((bfu*)(WSB + WS_CAT))
#define F32 ((bfu*)(WSB + WS_F32))
#define DIFF ((bfu*)(WSB + WS_DIFF))
#define DIFF1 ((bfu*)(WSB + WS_DIFF1))
#define KVT ((float*)(WSB + WS_KVT))
#define RT ((bfu*)(WSB + WS_RT))
#define RS ((float*)(WSB + WS_RS))
#define x_in karg(0)
#define out ((float*)karg(20))
    const int lo = args.ph_lo, hi = args.ph_hi;
    if (threadIdx.x < 64) MISC[threadIdx.x] = 0;
    __syncthreads();
    XcdBarrier bar = xcd_barrier_post(ctl + CW_BAR, (volatile LAS unsigned*)(MISC + 8));
    int ph = 0;
    if (lo < 0) cg::this_grid().sync();
#ifndef X_MASK
#define X_MASK 1023
#endif
#define XEN(k) (((X_MASK) >> (k)) & 1)
#ifndef X_REPMASK
#define X_REPMASK 0
#endif
#define XREP(k) (1 + (((X_REPMASK) >> (k)) & 1))
#define IN_PH() (lo <= ph && ph < hi)
#define SEAM() do { if (lo <= ph && ph + 1 < hi) { xcd_barrier(bar); if (XREP(10) > 1) xcd_barrier(bar); } ++ph; } while (0)

    if (XEN(0) && IN_PH()) for (int rep = 0; rep < XREP(0); ++rep) { PIN_TID();
        LAS float* scr = (LAS float*)(lds + wid * 16384);
        constexpr int I_IN = 32 * 200, I_OUT = 32 * 64, I_G = 32 * 176, I_D = 88 * 64, I_L = I_IN + I_OUT + 2 * I_G + I_D;
        for (int it = gw; it < DEPTH * I_L; it += NGW) {
            const int l = it / I_L; int r = it - l * I_L;
            if (r < I_IN) { const int kb = r / 200, nb = r % 200; p0_transpose_item(karg(2) + (size_t)l * DM * INW, DM, INW, WIN + (size_t)l * INW * DM, 32 * nb, scr, 64 * kb, 32 * nb, lane, karg(1) + l * DM); continue; } r -= I_IN;
            if (r < I_OUT) { const int kb = r / 64, nb = r % 64; p0_transpose_item(karg(13) + (size_t)l * DM * DM, DM, DM, WOUT + (size_t)l * DM * DM, 32 * nb, scr, 64 * kb, 32 * nb, lane, nullptr); continue; } r -= I_OUT;
            if (r < I_G) { const int kb = r / 176, nb = r % 176, n0 = 32 * nb; p0_transpose_item(karg(16) + (size_t)l * DM * FFH, DM, FFH, WGU + (size_t)l * NGU * DM, (n0 >> 7) * 256 + (n0 & 127), scr, 64 * kb, n0, lane, karg(15) + l * DM); continue; } r -= I_G;
            if (r < I_G) { const int kb = r / 176, nb = r % 176, n0 = 32 * nb; p0_transpose_item(karg(17) + (size_t)l * DM * FFH, DM, FFH, WGU + (size_t)l * NGU * DM, (n0 >> 7) * 256 + 128 + (n0 & 127), scr, 64 * kb, n0, lane, karg(15) + l * DM); continue; } r -= I_G;
            { const int kb = r / 64, nb = r % 64; p0_transpose_item(karg(18) + (size_t)l * FFH * DM, FFH, DM, WDN + (size_t)l * DM * FFH, 32 * nb, scr, 64 * kb, 32 * nb, lane, nullptr); }
        }
        for (int e = blockIdx.x * NTHR + tid; e < DEPTH * 4 * 128 * 128; e += G * NTHR) { const int s_ = e & 127, t_ = (e >> 7) & 127; SGUW[e] = (bfu)f2bf(s_ <= t_ ? karg(11)[e] : 0.f); }
        xn_rows(x_in, XN, RS, gw, NGW, lane);
        __syncthreads();
    }
    SEAM();

    for (int l = 0; l < DEPTH; ++l) {
#define lambda_init (0.8f - 0.6f * expf(-0.3f * (float)l))
        if (XEN(1) && IN_PH()) for (int rep = 0; rep < XREP(1); ++rep) { PIN_TID();
            pg8::Gemm g{XN, WIN + (size_t)l * INW * DM, M, INW, DM}; pg8::StaticOrder S; S.init(M, INW - 256 * XTAIL, G, (int)blockIdx.x);
            pg8::EpiProj E{PROJ, INW, RS};
            pg8::gemm_phase<pg8::EpiProj, pg8::StaticOrder, PG8ALIGN, PG8SP2>(lds, g, S, E);
        }
        SEAM();
        if (XEN(3) && IN_PH()) for (int rep = 0; rep < XREP(3); ++rep) { PIN_TID();
            unsigned* cw = ctl + CW_QUEUE + 1024 * l + 32 * rep;
#define PULL_ISSUE(hd) ((tid == 0) ? (int)__hip_atomic_fetch_add((hd), 1u, __ATOMIC_RELAXED, __HIP_MEMORY_SCOPE_AGENT) : 0)
#define BCAST(v) ({ if (tid == 0) MISC[0] = (v); __syncthreads(); const int u__ = __builtin_amdgcn_readfirstlane(MISC[0]); __syncthreads(); u__; })
            qk_norms(lds, PROJ, cw + 64 * 15); publish(cw + 64 * 14);
            { int nx = PULL_ISSUE(cw);
              for (;;) {
                const int u = BCAST(nx);
                if (u >= 768 + 96) break;
                nx = PULL_ISSUE(cw);
                if (u < 768) { kv_unit(lds, PROJ, KVT, u); publish(cw + 64 + (u >> 6)); }
                else { const int s_ = u - 768; wait_ge(cw + 64 + (s_ >> 3), 64u, cw + 192); scan_unit(KVT, RT, s_); publish(cw + 128 + (s_ >> 3)); }
              } }
#ifndef X_NO_ATTN
            wait_ge(cw + 64 * 14, (unsigned)G, cw + 192);
            { const int myx = (int)(xb_xcc_id() & 7u);
              unsigned stealmask = 1u;
              for (int k = 0; k < 8; ++k) { if (!((stealmask >> k) & 1u)) continue;
                const int x = (myx + k) & 7; unsigned* hd = cw + 64 * (4 + x);
                for (;;) {
                    const int j = BCAST(PULL_ISSUE(hd));
                    if (j >= 96) break;
                    const int ou_ = __builtin_amdgcn_readfirstlane((int)ATTN_ORDER.u[x < 4 ? 0 : 1][j]), qb = ou_ & 31, sl_ = ou_ >> 5, b = (x & 3) >> 1, mp = x & 1, h = (x < 4) ? (sl_ == 0 ? 0 : (sl_ == 1 ? 3 : 5)) : (sl_ == 0 ? 1 : (sl_ == 1 ? 2 : 4));
                    const float cs = __builtin_bit_cast(float, __builtin_amdgcn_readfirstlane(__builtin_bit_cast(int, exp2f(-8.f * (float)(h + 1) / 6.f) * LOG2E)));
                    const attn_body::bf16* Pj = (const attn_body::bf16*)PROJ; float* Dg = (float*)((mp ? DIFF1 : DIFF) + h * 128);
                    int t0 = 0;
                    { const unsigned* nwp = cw + 64 * 15 + b * 24 + h * 2 + mp;
                      const float nq = __uint_as_float(__hip_atomic_load(nwp, __ATOMIC_RELAXED, __HIP_MEMORY_SCOPE_AGENT)), nk = __uint_as_float(__hip_atomic_load(nwp + 12, __ATOMIC_RELAXED, __HIP_MEMORY_SCOPE_AGENT));
                      const float Bq = sqrtf(nq * nk) * 1.01f + 0.01f, lim = 256.f * (float)qb - 63.f - (2.f * Bq + 160.f) / cs;
                      if (lim >= 0.f) { const int tmax = (int)floorf(lim * (1.f / 64.f)); t0 = (tmax + 1) & ~1; if (t0 > 4 * qb) t0 = 4 * qb; }
                      t0 = __builtin_amdgcn_readfirstlane(t0); }
                    attn_body::attn_unit<ATT_THRL>(b, qb, XSKIP ? t0 : 0, Pj + C_DQ + h * 128 + 64 * mp, Pj + C_DK + h * 128 + 64 * mp, Pj + C_DV + h * 128, Dg, cs, 0.f, (char*)lds_raw);
                }
                if (k == 0) {
                    int av = 0;
                    if (tid < 8) av = (tid > 0 && __hip_atomic_load(cw + 64 * (4 + ((myx + tid) & 7)), __ATOMIC_RELAXED, __HIP_MEMORY_SCOPE_AGENT) < 96u) ? (1 << tid) : 0;
                    if (tid < 8) { av |= __shfl_xor(av, 1); av |= __shfl_xor(av, 2); av |= __shfl_xor(av, 4); }
                    stealmask = (unsigned)BCAST(av);
                }
              } }
#endif
            { int nx = PULL_ISSUE(cw + 64 * 12);
              for (;;) {
                const int u = BCAST(nx);
                if (u >= 768 + 512) break;
                nx = PULL_ISSUE(cw + 64 * 12);
                if (u < 768) { wait_ge(cw + 128 + (u >> 6), 8u, cw + 192); ret_unit(lds, PROJ, RT, karg(3) + l * 768, CAT, u); }
                else sgu_unit(lds, PROJ, SGUW + (size_t)l * 65536, karg(9) + l * 512, karg(10) + l * 512, karg(12) + l * 512, CAT, u - 768);
              } }
#undef PULL_ISSUE
#undef BCAST
        }
        SEAM();
        if (XEN(4) && IN_PH()) for (int rep = 0; rep < XREP(4); ++rep) { PIN_TID();
            float lam;
            { const float a = (lane < 64) ? karg(4)[l * 64 + lane] * karg(5)[l * 64 + lane] : 0.f, b_ = karg(6)[l * 64 + lane] * karg(7)[l * 64 + lane];
              lam = expf(wave_sum(a)) - expf(wave_sum(b_)) + lambda_init; lam = __builtin_bit_cast(float, __builtin_amdgcn_readfirstlane(__builtin_bit_cast(int, lam))); }
            diff_final(DIFF, DIFF1, lam, karg(8) + l * 768, 1.f - lambda_init, CAT, gw, NGW, lane);
        }
        SEAM();
        if (XEN(5) && IN_PH()) for (int rep = 0; rep < XREP(5); ++rep) { PIN_TID();
            pg8::Gemm g{CAT, WOUT + (size_t)l * DM * DM, M, DM, DM}; pg8::StaticOrder S; S.init(M, DM, G, (int)blockIdx.x);
            pg8::EpiBf E{F32, DM};
            pg8::gemm_phase<pg8::EpiBf, pg8::StaticOrder, PG8ALIGN, PG8SP2>(lds, g, S, E);
        }
        SEAM();
        if (XEN(6) && IN_PH()) for (int rep = 0; rep < XREP(6); ++rep) { PIN_TID(); if (XREP(6) > 1 && rep == 0) norm_rows<false, true>(F32, XN, karg(14) + l * DM, RS, nullptr, gw, NGW, lane, PROJ); else norm_rows<false>(F32, XN, karg(14) + l * DM, RS, nullptr, gw, NGW, lane); }
        SEAM();
        if (XEN(7) && IN_PH()) for (int rep = 0; rep < XREP(7); ++rep) { PIN_TID();
            pg8::Gemm g{XN, WGU + (size_t)l * NGU * DM, M, NGU, DM}; pg8::StaticOrder S; S.init(M, NGU, G, (int)blockIdx.x);
            pg8::EpiSwiGLU E{HID, FFH, RS};
            pg8::gemm_phase<pg8::EpiSwiGLU, pg8::StaticOrder, PG8ALIGN, PG8SP2>(lds, g, S, E);
        }
        SEAM();
        if (XEN(8) && IN_PH()) for (int rep = 0; rep < XREP(8); ++rep) { PIN_TID();
            pg8::Gemm g{HID, WDN + (size_t)l * DM * FFH, M, DM, FFH}; pg8::StaticOrder S; S.init(M, DM, G, (int)blockIdx.x);
            pg8::EpiBf E{F32, DM};
            pg8::gemm_phase<pg8::EpiBf, pg8::StaticOrder, PG8ALIGN, PG8SP2>(lds, g, S, E);
        }
        SEAM();
        if (XEN(9) && IN_PH()) for (int rep = 0; rep < XREP(9); ++rep) { PIN_TID(); if (XREP(9) > 1 && rep == 0) norm_rows<false, true>(F32, XN, karg(19) + l * DM, RS, nullptr, gw, NGW, lane, PROJ); else if (l + 1 < DEPTH) norm_rows<false>(F32, XN, karg(19) + l * DM, RS, nullptr, gw, NGW, lane); else norm_rows<true>(F32, XN, karg(19) + l * DM, nullptr, out, gw, NGW, lane); }
        SEAM();
    }
}
#undef lambda_init
#undef out
#undef x_in
#undef ctl
constexpr int N_PHASES = 1 + 8 * DEPTH;

extern "C" void kernel_launch(void* const* d_in, const int* in_sizes, int n_in, void* d_out, int out_size, void* d_ws, size_t ws_size, hipStream_t stream) {
    static int grid = 0;
    if (grid == 0) {
        if (n_in != 20 || in_sizes[0] != M * DM || out_size != M * DM || ws_size < WS_END) { fprintf(stderr, "kernel_launch: unexpected shapes / workspace (n_in %d, in0 %d, out %d, ws %zu)\n", n_in, n_in > 0 ? in_sizes[0] : -1, out_size, ws_size); grid = -1; return; }
        int dev = 0, cus = 0, per_cu = 0;
        if (hipGetDevice(&dev) != hipSuccess || hipDeviceGetAttribute(&cus, hipDeviceAttributeMultiprocessorCount, dev) != hipSuccess) { grid = -1; return; }
        if (hipFuncSetAttribute((const void*)fwd, hipFuncAttributeMaxDynamicSharedMemorySize, LDS_BYTES) != hipSuccess) { fprintf(stderr, "kernel_launch: hipFuncSetAttribute failed\n"); grid = -1; return; }
        if (hipOccupancyMaxActiveBlocksPerMultiprocessor(&per_cu, (const void*)fwd, NTHR, LDS_BYTES) != hipSuccess || per_cu < 1) { fprintf(stderr, "kernel_launch: occupancy query says %d\n", per_cu); per_cu = 1; }
        (void)hipGetLastError();
        grid = cus * (per_cu > 1 ? 1 : per_cu);
    }
    if (grid < 0) return;
    (void)hipMemsetAsync((char*)d_ws + WS_CTL, 0, CTL_ZERO_BYTES, stream);
    Args a{};
    for (int i = 0; i < 20; ++i) a.in[i] = (const float*)d_in[i];
    a.out = (float*)d_out; a.ws = (unsigned char*)d_ws;
#if MK_ONE_LAUNCH
    a.ph_lo = 0; a.ph_hi = N_PHASES;
    void* kargs[] = {&a};
    hipError_t e = hipLaunchCooperativeKernel((const void*)fwd, dim3(grid), dim3(NTHR), kargs, LDS_BYTES, stream);
    if (e != hipSuccess) fprintf(stderr, "kernel_launch: cooperative launch failed: %s (grid %d)\n", hipGetErrorString(e), grid);
#else
    for (int p = 0; p < N_PHASES; ++p) { a.ph_lo = p; a.ph_hi = p + 1; hipLaunchKernelGGL(fwd, dim3(grid), dim3(NTHR), LDS_BYTES, stream, a); }
#endif
}
```

```cpp
#include <hip/hip_runtime.h>
#include <hip/hip_cooperative_groups.h>
#include <hip/hip_bf16.h>
#include <cstdio>
#include <cstdint>
#include <cmath>
namespace pg8 {
#define PG8_LAS __attribute__((address_space(3)))
typedef unsigned short bf16_t;
typedef short bf16x8 __attribute__((ext_vector_type(8)));
typedef float f32x4 __attribute__((ext_vector_type(4)));
typedef unsigned u32x4 __attribute__((ext_vector_type(4)));
constexpr int BM = 256, BK = 64, HALF = 128, HTB = HALF * BK * 2  , STAGE_BYTES = 8 * HTB, NXCD = 8, WGM = 8;

__host__ __device__ __forceinline__ int lds_byte(int r, int c) { const int st = (r >> 4) * 2 + (c >> 5), rr = r & 15, cc = c & 31, ob = rr * 64 + cc * 2; return st * 1024 + (ob ^ (((ob >> 9) & 1) << 5)); }
__host__ __device__ __forceinline__ void stage_rc(int b, int& R, int& C) { const int st = b / 1024, sb = b % 1024, swz = sb ^ (((sb >> 9) & 1) << 5); R = (st >> 1) * 16 + swz / 64; C = (st & 1) * 32 + (swz % 64) / 2; }
__host__ __device__ __forceinline__ int perm32(int rho) { const int n = rho >> 4, i = rho & 15; return 8 * (i >> 2) + 4 * n + (i & 3); }

struct Unit { int pm, pn; };
struct Gemm { const bf16_t* A; const bf16_t* Bt; int M, N, K; };

struct StaticOrder {
    int nM, nN, nwg, G, c;
    __host__ __device__ void init(int M, int N, int G_, int c_) { nM = M / BM; nN = N / BM; nwg = nM * nN; G = G_; c = c_; }
    __host__ __device__ bool next(int i, Unit& u) const {
        const long L = (long)i * G + c; if (L >= nwg) return false;
        int wgid = (int)L; { const int q = nwg / NXCD, r = nwg % NXCD, xcd = wgid % NXCD, off = wgid / NXCD; wgid = (xcd < r ? xcd * (q + 1) : r * (q + 1) + (xcd - r) * q) + off; }
        const int nig = WGM * nN, gid = wgid / nig, fm = gid * WGM, gsz = (nM - fm) < WGM ? (nM - fm) : WGM;
        u.pm = fm + ((wgid % nig) % gsz); u.pn = (wgid % nig) / gsz; return true;
    }
    __device__ __forceinline__ void a_ready(const Unit&) const {}
    __device__ __forceinline__ void done(const Unit&) const {}
};

typedef float f32x2c_t __attribute__((ext_vector_type(2))); typedef __bf16 bf16x2c_t __attribute__((ext_vector_type(2)));
__device__ __forceinline__ unsigned cvt_pk_bf16(float lo, float hi) { f32x2c_t v = {lo, hi}; bf16x2c_t b = __builtin_convertvector(v, bf16x2c_t); return __builtin_bit_cast(unsigned, b); }
typedef float f32x2 __attribute__((ext_vector_type(2)));
struct OneUnit {
    int pm, pn;
    __device__ __forceinline__ bool next(int i, Unit& u) const { if (i) return false; u.pm = pm; u.pn = pn; return true; }
    __device__ __forceinline__ void a_ready(const Unit&) const {}
    __device__ __forceinline__ void done(const Unit&) const {}
};
struct EpiProj {
    static constexpr bool PERM = true, AFTER_DRAIN = false;
    bf16_t* O; int ldc; const float* rs;
    __device__ __forceinline__ void operator()(const f32x4 (&acc)[2][2][4][2], const Unit& u, int wr, int wc, int fr, int fq) const {
        const float sc0 = (u.pn >= 3 && u.pn < 6) ? 0.08838834764831845f : ((u.pn >= 12 && u.pn < 15) ? 0.125f * 1.4426950408889634f : 1.f);
        const int row0 = u.pm * BM + wr * 64 + fr, col0 = u.pn * BM + wc * 32 + 8 * fq;
#pragma unroll
        for (int ai = 0; ai < 2; ++ai)
#pragma unroll
            for (int m = 0; m < 4; ++m) { bf16_t* rowp = O + (size_t)(row0 + ai * HALF + m * 16) * ldc + col0; const float sc = sc0 * rs[row0 + ai * HALF + m * 16];
#pragma unroll
                for (int bj = 0; bj < 2; ++bj) { const f32x4 v0 = acc[ai][bj][m][0] * sc, v1 = acc[ai][bj][m][1] * sc;
                    u32x4 w; w.x = cvt_pk_bf16(v0[0], v0[1]); w.y = cvt_pk_bf16(v0[2], v0[3]); w.z = cvt_pk_bf16(v1[0], v1[1]); w.w = cvt_pk_bf16(v1[2], v1[3]);
                    *(u32x4*)(rowp + bj * HALF) = w; } }
    }
};
struct EpiBf {
    static constexpr bool PERM = true, AFTER_DRAIN = false;
    bf16_t* O; int ldc;
    __device__ __forceinline__ void operator()(const f32x4 (&acc)[2][2][4][2], const Unit& u, int wr, int wc, int fr, int fq) const {
        const int row0 = u.pm * BM + wr * 64 + fr, col0 = u.pn * BM + wc * 32 + 8 * fq;
#pragma unroll
        for (int ai = 0; ai < 2; ++ai)
#pragma unroll
            for (int m = 0; m < 4; ++m) { bf16_t* rowp = O + (size_t)(row0 + ai * HALF + m * 16) * ldc + col0;
#pragma unroll
                for (int bj = 0; bj < 2; ++bj) { const f32x4 v0 = acc[ai][bj][m][0], v1 = acc[ai][bj][m][1];
                    u32x4 w; w.x = cvt_pk_bf16(v0[0], v0[1]); w.y = cvt_pk_bf16(v0[2], v0[3]); w.z = cvt_pk_bf16(v1[0], v1[1]); w.w = cvt_pk_bf16(v1[2], v1[3]);
                    *(u32x4*)(rowp + bj * HALF) = w; } }
    }
};
struct EpiF32 {
    static constexpr bool PERM = false, AFTER_DRAIN = false;
    float* O; int ldc;
    __device__ __forceinline__ void operator()(const f32x4 (&acc)[2][2][4][2], const Unit& u, int wr, int wc, int fr, int fq) const {
        const int col0 = u.pn * BM + wc * 32 + 4 * fq;
#pragma unroll
        for (int ai = 0; ai < 2; ++ai)
#pragma unroll
            for (int m = 0; m < 4; ++m) { float* rowp = O + (size_t)(u.pm * BM + ai * HALF + wr * 64 + m * 16 + fr) * ldc + col0;
#pragma unroll
                for (int bj = 0; bj < 2; ++bj)
#pragma unroll
                    for (int n = 0; n < 2; ++n) *(f32x4*)(rowp + bj * HALF + n * 16) = acc[ai][bj][m][n]; }
    }
};
struct EpiSwiGLU {
    static constexpr bool PERM = true, AFTER_DRAIN = false;
    bf16_t* O; int ldc; const float* rs;
    __device__ __forceinline__ static float sw(float g, float u) { return g * __builtin_amdgcn_rcpf(1.f + __builtin_amdgcn_exp2f(-1.4426950408889634f * g)) * u; }
    __device__ __forceinline__ void operator()(const f32x4 (&acc)[2][2][4][2], const Unit& u, int wr, int wc, int fr, int fq) const {
        const int row0 = u.pm * BM + wr * 64 + fr, col0 = u.pn * HALF + wc * 32 + 8 * fq;
#pragma unroll
        for (int ai = 0; ai < 2; ++ai)
#pragma unroll
            for (int m = 0; m < 4; ++m) { bf16_t* rowp = O + (size_t)(row0 + ai * HALF + m * 16) * ldc + col0;
                const float r_ = rs[row0 + ai * HALF + m * 16];
                const f32x4 g0 = acc[ai][0][m][0] * r_, g1 = acc[ai][0][m][1] * r_, u0 = acc[ai][1][m][0] * r_, u1 = acc[ai][1][m][1] * r_;
                u32x4 w; w.x = cvt_pk_bf16(sw(g0[0], u0[0]), sw(g0[1], u0[1])); w.y = cvt_pk_bf16(sw(g0[2], u0[2]), sw(g0[3], u0[3]));
                w.z = cvt_pk_bf16(sw(g1[0], u1[0]), sw(g1[1], u1[1])); w.w = cvt_pk_bf16(sw(g1[2], u1[2]), sw(g1[3], u1[3]));
                *(u32x4*)rowp = w; }
    }
};

template <class Epi, class Sched, bool ALIGN_EPI = false, bool SP2 = false>
__device__ __forceinline__ void gemm_phase(PG8_LAS unsigned char* lds, const Gemm g, const Sched& S, const Epi& E) {
    int tid = threadIdx.x; asm volatile("" : "+v"(tid)); const int wid = __builtin_amdgcn_readfirstlane(tid >> 6), lane = tid & 63, wr = wid >> 2, wc = wid & 3, fr = lane & 15, fq = lane >> 4;
    const int K = g.K, nt = K / BK;
    unsigned voffA[2], voffB[2];
#pragma unroll
    for (int i = 0; i < 2; ++i) { int R, C; stage_rc(tid * 16 + i * 8192, R, C); const int Rb = Epi::PERM ? ((R & ~31) + perm32(R & 31)) : R;
        voffA[i] = (unsigned)(R * K + C) * 2u; voffB[i] = (unsigned)(Rb * K + C) * 2u; }
    const size_t kstep = (size_t)(BK * 2);
    const size_t hstep = (size_t)HALF * K * 2;
    const size_t tstep = 2 * hstep;
    const unsigned ldsw = (unsigned)wid * 1024u;
    const int aoff = lds_byte(wr * 64 + fr, fq * 8), boff = lds_byte(wc * 32 + fr, fq * 8);
#define PG8_SA(b, h) (((b) * 2 + (h)) * HTB)
#define PG8_SB(b, h) ((4 + (b) * 2 + (h)) * HTB)
#define PG8_STAGE(bufoff, gbase, voff) do { _Pragma("unroll") for (int _i = 0; _i < 2; ++_i) \
        __builtin_amdgcn_global_load_lds((const unsigned*)((const char*)(gbase) + (voff)[_i]), (PG8_LAS unsigned*)(lds + (bufoff) + ldsw + _i * 8192), 16, 0, 0); } while (0)
#define PG8_LDA(dst, b, h) do { _Pragma("unroll") for (int m = 0; m < 4; ++m) _Pragma("unroll") for (int k = 0; k < 2; ++k) dst[m][k] = *(const PG8_LAS bf16x8*)(lds + PG8_SA(b, h) + aoff + m * 2048 + k * 1024); } while (0)
#define PG8_LDB(dst, b, h) do { _Pragma("unroll") for (int n = 0; n < 2; ++n) _Pragma("unroll") for (int k = 0; k < 2; ++k) dst[n][k] = *(const PG8_LAS bf16x8*)(lds + PG8_SB(b, h) + boff + n * 2048 + k * 1024); } while (0)
#define PG8_MMA(ai, bj, At, Bt) do { __builtin_amdgcn_s_setprio(1); _Pragma("unroll") for (int m = 0; m < 4; ++m) _Pragma("unroll") for (int n = 0; n < 2; ++n) _Pragma("unroll") for (int k = 0; k < 2; ++k) \
        acc[ai][bj][m][n] = __builtin_amdgcn_mfma_f32_16x16x32_bf16(Bt[n][k], At[m][k], acc[ai][bj][m][n], 0, 0, 0); __builtin_amdgcn_s_setprio(0); } while (0)
#define PG8_WAIT_V(n) asm volatile("s_waitcnt vmcnt(" #n ")" ::: "memory")
#define PG8_WAIT_L(n) asm volatile("s_waitcnt lgkmcnt(" #n ")" ::: "memory")
#define PG8_BAR __builtin_amdgcn_s_barrier()
#define PG8_SCHED __builtin_amdgcn_sched_barrier(0)
    Unit cur, nxt; int ui = 0;
    if (!S.next(0, cur)) return;
    f32x4 acc[2][2][4][2];
#pragma unroll
    for (int a = 0; a < 2; ++a)
#pragma unroll
        for (int b = 0; b < 2; ++b)
#pragma unroll
            for (int m = 0; m < 4; ++m)
#pragma unroll
                for (int n = 0; n < 2; ++n) acc[a][b][m][n] = (f32x4){0.f, 0.f, 0.f, 0.f};
    bf16x8 At[4][2], B0[2][2], B1[2][2];
    const char* cA = (const char*)g.A + (size_t)cur.pm * tstep; const char* cB = (const char*)g.Bt + (size_t)cur.pn * tstep;
    S.a_ready(cur);
    if constexpr (SP2) {
        PG8_STAGE(PG8_SB(0, 0), cB, voffB); PG8_STAGE(PG8_SB(0, 1), cB + hstep, voffB); PG8_STAGE(PG8_SA(0, 0), cA, voffA); PG8_STAGE(PG8_SA(0, 1), cA + hstep, voffA);
        if (wr == 1) PG8_BAR;
        PG8_WAIT_V(2); PG8_BAR;
        PG8_STAGE(PG8_SB(1, 0), cB + kstep, voffB); PG8_STAGE(PG8_SA(1, 0), cA + kstep, voffA); PG8_STAGE(PG8_SB(1, 1), cB + hstep + kstep, voffB);
        PG8_WAIT_V(6); PG8_BAR;
    } else {
        PG8_STAGE(PG8_SB(0, 0), cB, voffB); PG8_STAGE(PG8_SA(0, 0), cA, voffA); PG8_STAGE(PG8_SB(0, 1), cB + hstep, voffB); PG8_STAGE(PG8_SA(0, 1), cA + hstep, voffA);
        if (wr == 1) PG8_BAR;
        PG8_WAIT_V(4); PG8_BAR;
        PG8_STAGE(PG8_SB(1, 0), cB + kstep, voffB); PG8_STAGE(PG8_SA(1, 0), cA + kstep, voffA); PG8_STAGE(PG8_SB(1, 1), cB + hstep + kstep, voffB);
        PG8_WAIT_V(6); PG8_BAR;
    }
    for (;;) {
        const bool has_next = S.next(ui + 1, nxt);
        const char* nA = has_next ? (const char*)g.A + (size_t)nxt.pm * tstep : cA; const char* nB = has_next ? (const char*)g.Bt + (size_t)nxt.pn * tstep : cB;
        for (int t = 0; t < nt; t += 2) {
            const bool last = (t == nt - 2);
            const char* a1 = cA + (size_t)(t + 1) * kstep;
            const char* a2 = last ? nA : cA + (size_t)(t + 2) * kstep; const char* b2 = last ? nB : cB + (size_t)(t + 2) * kstep;
            const char* a3 = a2 + kstep; const char* b3 = b2 + kstep;
            if (last && has_next) S.a_ready(nxt);
            if constexpr (SP2) {
            PG8_LDB(B0, 0, 0); PG8_LDB(B1, 0, 1); PG8_SCHED; PG8_LDA(At, 0, 0); PG8_STAGE(PG8_SA(1, 1), a1 + hstep, voffA);
            PG8_WAIT_V(8); PG8_WAIT_L(0); PG8_BAR; PG8_MMA(0, 0, At, B0); PG8_MMA(0, 1, At, B1); PG8_BAR; PG8_SCHED;
            PG8_LDA(At, 0, 1); PG8_STAGE(PG8_SB(0, 0), b2, voffB); PG8_STAGE(PG8_SB(0, 1), b2 + hstep, voffB); PG8_STAGE(PG8_SA(0, 0), a2, voffA);
            PG8_WAIT_V(8); PG8_WAIT_L(0); PG8_BAR; PG8_MMA(1, 0, At, B0); PG8_MMA(1, 1, At, B1); PG8_BAR; PG8_SCHED;
            PG8_LDB(B0, 1, 0); PG8_LDB(B1, 1, 1); PG8_SCHED; PG8_LDA(At, 1, 0); PG8_STAGE(PG8_SA(0, 1), a2 + hstep, voffA);
            PG8_WAIT_V(8); PG8_WAIT_L(0); PG8_BAR; PG8_MMA(0, 0, At, B0); PG8_MMA(0, 1, At, B1); PG8_BAR; PG8_SCHED;
            PG8_LDA(At, 1, 1); PG8_STAGE(PG8_SB(1, 0), b3, voffB); PG8_STAGE(PG8_SB(1, 1), b3 + hstep, voffB); PG8_STAGE(PG8_SA(1, 0), a3, voffA);
            PG8_WAIT_V(8); PG8_WAIT_L(0); PG8_BAR; PG8_MMA(1, 0, At, B0); PG8_MMA(1, 1, At, B1); PG8_BAR; PG8_SCHED;
            } else {
            PG8_LDB(B0, 0, 0); PG8_SCHED; PG8_LDA(At, 0, 0); PG8_STAGE(PG8_SA(1, 1), a1 + hstep, voffA);
            PG8_WAIT_L(8); PG8_BAR; PG8_WAIT_L(0); PG8_MMA(0, 0, At, B0); PG8_BAR; PG8_SCHED;
            PG8_LDB(B1, 0, 1); PG8_STAGE(PG8_SB(0, 0), b2, voffB);
            PG8_BAR; PG8_WAIT_L(0); PG8_MMA(0, 1, At, B1); PG8_BAR;
            PG8_LDA(At, 0, 1); PG8_STAGE(PG8_SA(0, 0), a2, voffA);
            PG8_BAR; PG8_WAIT_L(0); PG8_MMA(1, 0, At, B0); PG8_BAR; PG8_SCHED;
            PG8_STAGE(PG8_SB(0, 1), b2 + hstep, voffB);
            PG8_WAIT_V(6); PG8_BAR; PG8_MMA(1, 1, At, B1); PG8_BAR;
            PG8_LDB(B0, 1, 0); PG8_SCHED; PG8_LDA(At, 1, 0); PG8_STAGE(PG8_SA(0, 1), a2 + hstep, voffA);
            PG8_WAIT_L(8); PG8_BAR; PG8_WAIT_L(0); PG8_MMA(0, 0, At, B0); PG8_BAR; PG8_SCHED;
            PG8_LDB(B1, 1, 1); PG8_STAGE(PG8_SB(1, 0), b3, voffB);
            PG8_BAR; PG8_WAIT_L(0); PG8_MMA(0, 1, At, B1); PG8_BAR;
            PG8_LDA(At, 1, 1); PG8_STAGE(PG8_SA(1, 0), a3, voffA);
            PG8_BAR; PG8_WAIT_L(0); PG8_MMA(1, 0, At, B0); PG8_BAR; PG8_SCHED;
            PG8_STAGE(PG8_SB(1, 1), b3 + hstep, voffB);
            PG8_WAIT_V(6); PG8_BAR; PG8_MMA(1, 1, At, B1); PG8_BAR;
            }
        }
        if constexpr (ALIGN_EPI) { if (wr == 0) PG8_BAR; }
        if constexpr (!Epi::AFTER_DRAIN) { E(acc, cur, wr, wc, fr, fq); S.done(cur); }
        if (!has_next) break;
#pragma unroll
        for (int a = 0; a < 2; ++a)
#pragma unroll
            for (int b = 0; b < 2; ++b)
#pragma unroll
                for (int m = 0; m < 4; ++m)
#pragma unroll
                    for (int n = 0; n < 2; ++n) acc[a][b][m][n] = (f32x4){0.f, 0.f, 0.f, 0.f};
        cur = nxt; cA = nA; cB = nB; ++ui;
        if constexpr (ALIGN_EPI) { if (wr == 1) PG8_BAR; }
    }
    PG8_WAIT_V(0);
    if constexpr (!ALIGN_EPI) { if (wr == 0) PG8_BAR; }
    PG8_BAR;
    if constexpr (Epi::AFTER_DRAIN) { E.fused(acc, cur, wr, wc, fr, fq, lds, wid, lane); S.done(cur); }
#undef PG8_SA
#undef PG8_SB
#undef PG8_STAGE
#undef PG8_LDA
#undef PG8_LDB
#undef PG8_MMA
#undef PG8_WAIT_V
#undef PG8_WAIT_L
#undef PG8_BAR
#undef PG8_SCHED
}
}

namespace attn_body {
using bf16=__hip_bfloat16;
using bf16x8=__attribute__((ext_vector_type(8)))short;
using s16x4=__attribute__((ext_vector_type(4)))short;
using f32x16=__attribute__((ext_vector_type(16)))float;
using u32x4=__attribute__((ext_vector_type(4)))unsigned;
constexpr int BATCH=2,SEQ=8192,D=64,DM=6400;
constexpr int NW=8,QBLK=32,QB=QBLK*NW,KVBLK=64,NQB=SEQ/QB;
constexpr int ATTN_PITCH=DM, ATTN_UNIT_ROWS=QB;
__device__ __forceinline__ int crow(int r,int hi){return (r&3)+8*(r>>2)+4*hi;}
#define SBAR() __builtin_amdgcn_sched_barrier(0)
__device__ __forceinline__ void cmask(f32x16&p0,f32x16&p1,int jb,int qrel,int hi){
  const float NEG=-INFINITY; int kb=64*jb+4*hi;
  #pragma unroll
  for(int r=0;r<16;++r){int kv=kb+(r&3)+8*(r>>2); if(kv>qrel)p0[r]=NEG; if(kv+32>qrel)p1[r]=NEG;}
}

constexpr int NSLOT=3, SLOTB=8192;
constexpr int LDS_K=0, LDS_V=NSLOT*SLOTB, LDS_WS=3*NSLOT*SLOTB, LDS_OST=LDS_WS+NW*64*4, LDS_BYTES=LDS_OST+NW*4096;
constexpr float C2=0.125f*1.4426950408889634f;
__device__ __forceinline__ void glds16(const void*gsrc,unsigned lds_dst){unsigned keep;
  asm volatile("s_mov_b32 %0, m0\n\ts_mov_b32 m0, %2\n\ts_nop 0\n\tglobal_load_lds_dwordx4 %1, off\n\ts_mov_b32 m0, %0":"=&s"(keep):"v"(gsrc),"s"(lds_dst):"memory");}
__device__ __forceinline__ float max3f(float a,float b,float c){float r;asm("v_max3_f32 %0, %1, %2, %3":"=v"(r):"v"(a),"v"(b),"v"(c));return r;}
__device__ __forceinline__ float max2f(float a,float b){float r;asm("v_max_f32_e32 %0, %1, %2":"=v"(r):"v"(a),"v"(b));return r;}
__device__ __forceinline__ float fadd_s(float a,float b){float r;asm("v_add_f32_e32 %0, %1, %2":"=v"(r):"v"(a),"v"(b));return r;}
__device__ __forceinline__ float fsub_s(float a,float b){float r;asm("v_sub_f32_e32 %0, %1, %2":"=v"(r):"v"(a),"v"(b));return r;}
typedef float f32x2_t __attribute__((ext_vector_type(2))); typedef __bf16 bf16x2_t __attribute__((ext_vector_type(2)));
__device__ __forceinline__ unsigned cvtpk_s(float lo,float hi){f32x2_t v={lo,hi};bf16x2_t b=__builtin_convertvector(v,bf16x2_t);return __builtin_bit_cast(unsigned,b);}
#define WAIT_BAR(N) asm volatile("s_waitcnt vmcnt(" #N ") lgkmcnt(0)\n\ts_barrier":::"memory")

__device__ __forceinline__ void qkt(f32x16&p0,f32x16&p1,const char*Kslot,const bf16x8*qr,int r32,int hi){
  const char*kb=Kslot+hi*1024+r32*16;
  #pragma unroll
  for(int d0=0;d0<4;++d0){
    const bf16x8 b0=*reinterpret_cast<const bf16x8*>(kb+d0*2048);
    const bf16x8 b1=*reinterpret_cast<const bf16x8*>(kb+d0*2048+512);
    {p0=__builtin_amdgcn_mfma_f32_32x32x16_bf16(b0,qr[d0],p0,0,0,0);p1=__builtin_amdgcn_mfma_f32_32x32x16_bf16(b1,qr[d0],p1,0,0,0);}}
}
typedef __attribute__((address_space(3))) const char* lds_cptr;
typedef short v4i16_t __attribute__((ext_vector_type(4)));
__device__ __forceinline__ void kload8(bf16x8*kf,lds_cptr kp){
  kf[0]=*(const __attribute__((address_space(3))) bf16x8*)(kp);      kf[1]=*(const __attribute__((address_space(3))) bf16x8*)(kp+512);
  kf[2]=*(const __attribute__((address_space(3))) bf16x8*)(kp+2048); kf[3]=*(const __attribute__((address_space(3))) bf16x8*)(kp+2560);
  kf[4]=*(const __attribute__((address_space(3))) bf16x8*)(kp+4096); kf[5]=*(const __attribute__((address_space(3))) bf16x8*)(kp+4608);
  kf[6]=*(const __attribute__((address_space(3))) bf16x8*)(kp+6144); kf[7]=*(const __attribute__((address_space(3))) bf16x8*)(kp+6656);
}
__device__ __forceinline__ void kload2(bf16x8*kf,lds_cptr kp,int j){ kf[2*j]=*(const __attribute__((address_space(3))) bf16x8*)(kp+j*2048); kf[2*j+1]=*(const __attribute__((address_space(3))) bf16x8*)(kp+j*2048+512); }
__device__ __forceinline__ s16x4 vtr(lds_cptr p){ return __builtin_bit_cast(s16x4,__builtin_amdgcn_ds_read_tr16_b64_v4i16((__attribute__((address_space(3))) v4i16_t*)p)); }
__device__ __forceinline__ float rowmax(const f32x16&p0,const f32x16&p1){
  float a=max3f(p0[0],p0[1],p1[0]),b=max3f(p0[2],p0[3],p1[1]);a=max3f(a,p1[2],p1[3]);
  #pragma unroll
  for(int r=4;r<16;r+=4){a=max3f(a,p0[r],p0[r+1]);b=max3f(b,p0[r+2],p0[r+3]);a=max3f(a,p1[r],p1[r+1]);b=max3f(b,p1[r+2],p1[r+3]);}
  const float m=max2f(a,b);
  auto rr=__builtin_amdgcn_permlane32_swap(__float_as_uint(m),__float_as_uint(m),false,false);
  return max2f(__uint_as_float(rr[0]),__uint_as_float(rr[1]));
}
__device__ __forceinline__ void pv(f32x16*o,int vb,bf16x8 pa0,bf16x8 pa1,bf16x8 pa2,bf16x8 pa3){
  #pragma unroll
  for(int d0=0;d0<4;++d0){s16x4 lo[4],hi[4];
    #pragma unroll
    for(int ks=0;ks<4;++ks){
      asm volatile("ds_read_b64_tr_b16 %0,%1 offset:%c2":"=&v"(lo[ks]):"v"(vb),"i"(d0*4096+ks*1024):"memory");
      asm volatile("ds_read_b64_tr_b16 %0,%1 offset:%c2":"=&v"(hi[ks]):"v"(vb),"i"(d0*4096+ks*1024+512):"memory");}
    asm volatile("s_waitcnt lgkmcnt(0)":::"memory");SBAR();
    #define PK(k) (bf16x8){lo[k][0],lo[k][1],lo[k][2],lo[k][3],hi[k][0],hi[k][1],hi[k][2],hi[k][3]}
    o[d0]=__builtin_amdgcn_mfma_f32_32x32x16_bf16(pa0,PK(0),o[d0],0,0,0);
    o[d0]=__builtin_amdgcn_mfma_f32_32x32x16_bf16(pa1,PK(1),o[d0],0,0,0);
    o[d0]=__builtin_amdgcn_mfma_f32_32x32x16_bf16(pa2,PK(2),o[d0],0,0,0);
    o[d0]=__builtin_amdgcn_mfma_f32_32x32x16_bf16(pa3,PK(3),o[d0],0,0,0);
    #undef PK
  }
}

#ifndef ATTN_STORE16
#define ATTN_STORE16(p,v) (*(u32x4*)(p)=(v))
#endif
template<int THRL> __device__ __forceinline__ void attn_unit(int b,int qb,int T0,const bf16*Q,const bf16*__restrict__ K,const bf16*__restrict__ V,float*Dg,float cs,float lam,char*shm){
  int tid=threadIdx.x; asm volatile("":"+v"(tid)); const int lane=tid&63,r32=lane&31,hi=lane>>5; const int wid=__builtin_amdgcn_readfirstlane(tid>>6);
  const long rowbase=(long)b*SEQ; const int q0=qb*QB;
  const bf16*Qw=Q+(rowbase+q0+wid*QBLK)*DM;
  const bf16*Kh=K+(rowbase+(long)T0*KVBLK)*DM,*Vh=V+(rowbase+(long)T0*KVBLK)*DM;
  const unsigned lds0=(unsigned)(uintptr_t)shm;
  float*wsf=(float*)(shm+LDS_WS)+wid*64;
  const bf16*ksrc=Kh+(long)lane*DM+wid*8;
  const bf16*vsrc=Vh+(long)(16*(wid&3)+(lane>>2))*DM+(wid>>2)*32+(lane&3)*8;
  const unsigned kdst=lds0+LDS_K+wid*1024, vdst=lds0+LDS_V+wid*1024;
  #define DMA_K(t,slot) glds16(ksrc+(long)(t)*KVBLK*DM,(unsigned)__builtin_amdgcn_readfirstlane(kdst+(slot)))
  #define DMA_V(t,slot) do{ glds16(vsrc+(long)(t)*KVBLK*DM,(unsigned)__builtin_amdgcn_readfirstlane(vdst+2*(slot))); glds16(vsrc+(long)(t)*KVBLK*DM+64,(unsigned)__builtin_amdgcn_readfirstlane(vdst+2*(slot)+8192)); }while(0)
  const int vb0=(int)(lds0+LDS_V)+((lane>>4)&1)*32+(lane&3)*8+(4*hi+((lane&15)>>2))*64;
  const char*Kbase=shm+LDS_K; bf16x8 kf[8];
  const lds_cptr shm3=(lds_cptr)shm; const lds_cptr kp0=shm3+LDS_K+hi*1024+r32*16; const lds_cptr vp0=shm3+LDS_V+((lane>>4)&1)*32+(lane&3)*8+(4*hi+((lane&15)>>2))*64;
  const int NT=(q0+QB)/KVBLK-T0;
  DMA_K(0,0);DMA_V(0,0);DMA_K(1,SLOTB);
  bf16x8 qr[4];
  #pragma unroll
  for(int d0=0;d0<4;++d0)qr[d0]=*reinterpret_cast<const bf16x8*>(&Qw[(long)r32*DM+d0*16+hi*8]);
  float mhat=0.f,l_reg=0.f;f32x16 o[4];o[0]=f32x16{};o[1]=f32x16{};o[2]=f32x16{};o[3]=f32x16{};const float cs32=cs*32.f; const float kb0=cs*(float)(4*hi-(q0+QB)+KVBLK*T0);
  #define BIN0(C0) do{ _Pragma("unroll") for(int r=0;r<16;++r)C0[r]=__builtin_fmaf(cs,(float)((r&3)+8*(r>>2)),sc_); }while(0)
  #define BIN1(C1) do{ _Pragma("unroll") for(int r=0;r<16;++r)C1[r]=__builtin_fmaf(cs,(float)((r&3)+8*(r>>2)),sc_+cs32); }while(0)
  const int qrel=wid*QBLK+r32;
  #define CMASK(P0,P1,t) do{int jb_=(t)-(NT-4); if(jb_>=0)cmask(P0,P1,jb_,qrel,hi);}while(0)
  bool resc=false;
  #define START(P0,P1) do{ const float rm=rowmax(P0,P1); resc=false; \
    { const float dl=rm; mhat=fadd_s(mhat,dl); \
      _Pragma("unroll") for(int r=0;r<16;++r){P0[r]=fsub_s(P0[r],dl);P1[r]=fsub_s(P1[r],dl);} \
      } \
    _Pragma("unroll") for(int r=0;r<16;++r)P0[r]=__builtin_amdgcn_exp2f(P0[r]); }while(0)
  #define RESC() do{ if(resc){ asm volatile("s_waitcnt lgkmcnt(0)":::"memory"); \
      _Pragma("unroll") for(int d_=0;d_<4;++d_) _Pragma("unroll") for(int r=0;r<16;++r)o[d_][r]*=wsf[crow(r,hi)]; } }while(0)
  f32x16 pA0,pA1,pB0,pB1;
  int sl_prev=0,sl_cur=0,sl_next=SLOTB;
  #define ROT() do{sl_prev=sl_cur;sl_cur=sl_next;sl_next=(sl_next==(NSLOT-1)*SLOTB)?0:sl_next+SLOTB;}while(0)
  DMA_K(2,2*SLOTB);
  WAIT_BAR(4);
  SBAR(); {float sc_=kb0-mhat; asm volatile("":"+v"(sc_)); BIN0(pA0); BIN1(pA1);} SBAR(); qkt(pA0,pA1,Kbase,qr,r32,hi);asm volatile("s_nop 15\n\ts_nop 7":"+v"(pA0),"+v"(pA1));CMASK(pA0,pA1,0);
  START(pA0,pA1);
  _Pragma("unroll") for(int r=0;r<16;++r)pA1[r]=__builtin_amdgcn_exp2f(pA1[r]);
  WAIT_BAR(0);
  DMA_K(3,0);DMA_V(1,SLOTB);
  ROT();
  kload8(kf,kp0+sl_cur);
  WAIT_BAR(3);
  s16x4 vlo[8],vhi[8]; u32x4 pw0,pw1,pw2,pw3;
  #define PKW(P,B) cvtpk_s(P[B],P[B+1])
  #define PAF(k) __builtin_bit_cast(bf16x8,pw##k)
  #define VFR(i) (bf16x8){vlo[i][0],vlo[i][1],vlo[i][2],vlo[i][3],vhi[i][0],vhi[i][1],vhi[i][2],vhi[i][3]}
  #define PIN(x) asm volatile("":"+v"(x))
  #define MX3(a,b,c) __builtin_fmaxf(__builtin_fmaxf((a),(b)),(c))
  #define GAPA(MF,A0,A1,A2,A3,W0,W1,PW) do{ MF; sacc+=A0; sacc+=A1; sacc+=A2; sacc+=A3; PIN(sacc); W0; W1; PIN(PW); SBAR(); }while(0)
  #define EX(v) __builtin_amdgcn_exp2f(v)
  #define GAPB(MF,X,B) do{ MF; X[B]=EX(X[B]); X[B+1]=EX(X[B+1]); X[B+2]=EX(X[B+2]); X[B+3]=EX(X[B+3]); PIN(X); SBAR(); }while(0)
  #define VRD(i) do{ vlo[i]=vtr(vp_+(((i)>>2)*4096+((i)&3)*1024)); vhi[i]=vtr(vp_+(((i)>>2)*4096+((i)&3)*1024+512)); }while(0)
  #define GAPB2(MF,X,B) do{ MF; X[B]=EX(X[B]); X[B+1]=EX(X[B+1]); PIN(X); SBAR(); }while(0)
  #define VRD2(i) do{ vlo[i]=vtr(vp_+((2+((i)>>2))*4096+((i)&3)*1024)); vhi[i]=vtr(vp_+((2+((i)>>2))*4096+((i)&3)*1024+512)); SBAR(); }while(0)
  #define KRD(G,j) do{ if(G){ kload2(kf,kp0+sl_next,j); SBAR(); } }while(0)
  #define STEP(C0,C1,P0,P1,t,GK,GV,GL) do{ SBAR(); const float sc_=(kb0+cs*(float)(64*(t)))-mhat; BIN0(C0); SBAR(); \
    const lds_cptr vp_=vp0+2*sl_prev; \
    VRD(0); SBAR(); float sacc=(P0[0]+P0[1]); \
    GAPA(C0=__builtin_amdgcn_mfma_f32_32x32x16_bf16(kf[0],qr[0],C0,0,0,0), P0[2],P0[3],P0[4],P0[5],     pw0[0]=PKW(P0,0), pw0[1]=PKW(P0,2), pw0); \
    VRD(4); SBAR(); BIN1(C1); SBAR(); GAPA(C1=__builtin_amdgcn_mfma_f32_32x32x16_bf16(kf[1],qr[0],C1,0,0,0), P0[6],P0[7],P0[8],P0[9],     pw0[2]=PKW(P0,4), pw0[3]=PKW(P0,6), pw0); \
    VRD(1); SBAR(); GAPA(C0=__builtin_amdgcn_mfma_f32_32x32x16_bf16(kf[2],qr[1],C0,0,0,0),   P0[10],P0[11],P0[12],P0[13], pw1[0]=PKW(P0,8), pw1[1]=PKW(P0,10), pw1); \
    VRD(5); SBAR(); GAPA(C1=__builtin_amdgcn_mfma_f32_32x32x16_bf16(kf[3],qr[1],C1,0,0,0),   P0[14],P0[15],P1[0],P1[1],   pw1[2]=PKW(P0,12),pw1[3]=PKW(P0,14), pw1); \
    VRD(2); SBAR(); GAPA(C0=__builtin_amdgcn_mfma_f32_32x32x16_bf16(kf[4],qr[2],C0,0,0,0),   P1[2],P1[3],P1[4],P1[5],     pw2[0]=PKW(P1,0), pw2[1]=PKW(P1,2), pw2); \
    VRD(6); SBAR(); GAPA(C1=__builtin_amdgcn_mfma_f32_32x32x16_bf16(kf[5],qr[2],C1,0,0,0),   P1[6],P1[7],P1[8],P1[9],     pw2[2]=PKW(P1,4), pw2[3]=PKW(P1,6), pw2); \
    VRD(3); SBAR(); GAPA(C0=__builtin_amdgcn_mfma_f32_32x32x16_bf16(kf[6],qr[3],C0,0,0,0),   P1[10],P1[11],P1[12],P1[13], pw3[0]=PKW(P1,8), pw3[1]=PKW(P1,10), pw3); \
    VRD(7); SBAR(); GAPA(C1=__builtin_amdgcn_mfma_f32_32x32x16_bf16(kf[7],qr[3],C1,0,0,0),   P1[14],P1[15],0.f,0.f,       pw3[2]=PKW(P1,12),pw3[3]=PKW(P1,14), pw3); \
    l_reg+=sacc; \
    if(GK){DMA_K((t)+3,sl_cur);} if(GV){DMA_V((t)+1,sl_next);} \
    CMASK(C0,C1,t); \
    { float a=MX3(C0[0],C0[1],C1[0]),b=MX3(C0[2],C0[3],C1[1]); a=MX3(a,C1[2],C1[3]); \
      _Pragma("unroll") for(int r=4;r<16;r+=4){a=MX3(a,C0[r],C0[r+1]);b=MX3(b,C0[r+2],C0[r+3]);a=MX3(a,C1[r],C1[r+1]);b=MX3(b,C1[r+2],C1[r+3]);} \
      float rm=__builtin_fmaxf(a,b); { auto rr=__builtin_amdgcn_permlane32_swap(__float_as_uint(rm),__float_as_uint(rm),false,false); rm=__builtin_fmaxf(__uint_as_float(rr[0]),__uint_as_float(rr[1])); } \
      resc=false; \
      if(__builtin_expect(__any(rm>(float)THRL),0)){ const float dl=__builtin_fmaxf(rm,0.f); mhat+=dl; \
        _Pragma("unroll") for(int r=0;r<16;++r){C0[r]-=dl;C1[r]-=dl;} \
        const float f=__builtin_amdgcn_exp2f(-dl); l_reg*=f; if(hi==0)wsf[r32]=f; resc=true; } } \
    SBAR(); \
    GAPB2(o[0]=__builtin_amdgcn_mfma_f32_32x32x16_bf16(PAF(0),VFR(0),o[0],0,0,0), C0,0); VRD2(0); \
    GAPB2(o[1]=__builtin_amdgcn_mfma_f32_32x32x16_bf16(PAF(0),VFR(4),o[1],0,0,0), C0,2); VRD2(4); \
    GAPB2(o[0]=__builtin_amdgcn_mfma_f32_32x32x16_bf16(PAF(1),VFR(1),o[0],0,0,0), C0,4); VRD2(1); \
    GAPB2(o[1]=__builtin_amdgcn_mfma_f32_32x32x16_bf16(PAF(1),VFR(5),o[1],0,0,0), C0,6); VRD2(5); \
    GAPB2(o[0]=__builtin_amdgcn_mfma_f32_32x32x16_bf16(PAF(2),VFR(2),o[0],0,0,0), C0,8); VRD2(2); \
    GAPB2(o[1]=__builtin_amdgcn_mfma_f32_32x32x16_bf16(PAF(2),VFR(6),o[1],0,0,0), C0,10); VRD2(6); \
    GAPB2(o[0]=__builtin_amdgcn_mfma_f32_32x32x16_bf16(PAF(3),VFR(3),o[0],0,0,0), C0,12); VRD2(3); \
    GAPB2(o[1]=__builtin_amdgcn_mfma_f32_32x32x16_bf16(PAF(3),VFR(7),o[1],0,0,0), C0,14); VRD2(7); \
    KRD(GL,0); GAPB2(o[2]=__builtin_amdgcn_mfma_f32_32x32x16_bf16(PAF(0),VFR(0),o[2],0,0,0), C1,0); \
    KRD(GL,1); GAPB2(o[3]=__builtin_amdgcn_mfma_f32_32x32x16_bf16(PAF(0),VFR(4),o[3],0,0,0), C1,2); \
    KRD(GL,2); GAPB2(o[2]=__builtin_amdgcn_mfma_f32_32x32x16_bf16(PAF(1),VFR(1),o[2],0,0,0), C1,4); \
    KRD(GL,3); GAPB2(o[3]=__builtin_amdgcn_mfma_f32_32x32x16_bf16(PAF(1),VFR(5),o[3],0,0,0), C1,6); \
    GAPB2(o[2]=__builtin_amdgcn_mfma_f32_32x32x16_bf16(PAF(2),VFR(2),o[2],0,0,0), C1,8); \
    GAPB2(o[3]=__builtin_amdgcn_mfma_f32_32x32x16_bf16(PAF(2),VFR(6),o[3],0,0,0), C1,10); \
    GAPB2(o[2]=__builtin_amdgcn_mfma_f32_32x32x16_bf16(PAF(3),VFR(3),o[2],0,0,0), C1,12); \
    GAPB2(o[3]=__builtin_amdgcn_mfma_f32_32x32x16_bf16(PAF(3),VFR(7),o[3],0,0,0), C1,14); \
    }while(0)
  int t=1;
  #undef CMASK
  #define CMASK(P0,P1,t) do{}while(0)
  for(;t+5<NT;t+=2){
    STEP(pB0,pB1,pA0,pA1,t,true,true,true);     WAIT_BAR(3); RESC(); ROT();
    STEP(pA0,pA1,pB0,pB1,t+1,true,true,true);   WAIT_BAR(3); RESC(); ROT();
  }
  #undef CMASK
  #define CMASK(P0,P1,t) do{int jb_=(t)-(NT-4); if(jb_>=0)cmask(P0,P1,jb_,qrel,hi);}while(0)
  #define ENDW(tt) do{ if((tt)+3<NT){WAIT_BAR(3);} else if((tt)+2<NT){WAIT_BAR(2);} else {WAIT_BAR(0);} }while(0)
  for(;t+1<NT;t+=2){
    STEP(pB0,pB1,pA0,pA1,t,(t+3<NT),(t+1<NT),(t+1<NT));       ENDW(t);   RESC(); ROT();
    STEP(pA0,pA1,pB0,pB1,t+1,(t+4<NT),(t+2<NT),(t+2<NT));     ENDW(t+1); RESC(); ROT();
  }
  STEP(pB0,pB1,pA0,pA1,NT-1,false,false,false); RESC();
  { float sacc=pB0[0]+pB0[1]; _Pragma("unroll") for(int r=2;r<16;++r)sacc+=pB0[r]; _Pragma("unroll") for(int r=0;r<16;++r)sacc+=pB1[r]; l_reg+=sacc;
    pw0=(u32x4){PKW(pB0,0),PKW(pB0,2),PKW(pB0,4),PKW(pB0,6)};pw1=(u32x4){PKW(pB0,8),PKW(pB0,10),PKW(pB0,12),PKW(pB0,14)};pw2=(u32x4){PKW(pB1,0),PKW(pB1,2),PKW(pB1,4),PKW(pB1,6)};pw3=(u32x4){PKW(pB1,8),PKW(pB1,10),PKW(pB1,12),PKW(pB1,14)};
    SBAR(); pv(o,vb0+2*sl_cur,PAF(0),PAF(1),PAF(2),PAF(3)); }
  #undef PKW
  #undef PAF
  #undef VFR
  #undef PIN
  #undef MX3
  #undef GAPA
  #undef GAPB
  #undef GAPB2
  #undef VRD2
  #undef EX
  #undef VRD
  #undef KRD
  #undef STEP
  #undef ENDW
  {auto rr=__builtin_amdgcn_permlane32_swap(__float_as_uint(l_reg),__float_as_uint(l_reg),false,false);l_reg=__uint_as_float(rr[0])+__uint_as_float(rr[1]);}
  if(hi==0)wsf[32+r32]=l_reg;asm volatile("s_waitcnt lgkmcnt(0)":::"memory");
  float rli[16];
  #pragma unroll
  for(int r=0;r<16;++r)rli[r]=__builtin_amdgcn_rcpf(wsf[32+crow(r,hi)]);
  { typedef __attribute__((address_space(1))) unsigned short gbf16; gbf16*Dw=(gbf16*)Dg+(rowbase+q0+wid*QBLK+4*hi)*768+r32; asm volatile("":"+v"(Dw));
    #pragma unroll
    for(int r=0;r<16;++r){
      #pragma unroll
      for(int d0=0;d0<4;++d0){ gbf16*p=Dw+((r&3)+8*(r>>2))*768+d0*32; const float v_=o[d0][r]*rli[r]; *p=(unsigned short)cvtpk_s(v_,v_); } } }
  asm volatile("s_waitcnt lgkmcnt(0)\n\ts_barrier":::"memory");
  #undef DMA_K
  #undef DMA_V
  #undef CMASK
  #undef START
  #undef RESC
  #undef ROT
  #undef BIN0
  #undef BIN1
}
constexpr int ATTN_LDS_BYTES=LDS_BYTES;
#undef SBAR
#undef WAIT_BAR
}

namespace cg = cooperative_groups;
#ifndef MK_ONE_LAUNCH
#define MK_ONE_LAUNCH 1
#endif
constexpr int NWAVES = 8, NTHR = 512;
constexpr int BATCH = 2, SEQ = 8192, DM = 2048, M = BATCH * SEQ, DEPTH = 4, INW = 6400, FFH = 5632, NGU = 2 * FFH;
constexpr int C_RQ = 0, C_RK = 768, C_RV = 1536, C_RG = 2304, C_DQ = 3072, C_DK = 3840, C_DV = 4608, C_SU = 5376, C_SV = 5888;
constexpr float EPS = 1e-6f, LOG2E = 1.4426950408889634f;
constexpr size_t MiB = 1u << 20;
constexpr size_t WS_CTL = 0, CTL_ZERO_BYTES = 65536, WS_SGUW = 1 * MiB, WS_RS = 1 * MiB + 768 * 1024, WS_WIN = 2 * MiB, WS_WOUT = 102 * MiB, WS_WGU = 134 * MiB, WS_WDN = 310 * MiB, WS_XN = 398 * MiB,
                 WS_PROJ = 462 * MiB, WS_HID = 462 * MiB, WS_CAT = 662 * MiB, WS_F32 = 726 * MiB, WS_DIFF = 726 * MiB, WS_KVT = 774 * MiB, WS_RT = 822 * MiB, WS_DIFF1 = 854 * MiB, WS_END = 902 * MiB;
constexpr int CW_QUEUE = 64;
constexpr int CW_BAR = 8192;
constexpr int TS = 136, TILE_B = 128 * TS * 2;
constexpr int RING_BYTES = 4 * TILE_B;
constexpr int MISC_OFF = RING_BYTES, LDS_BYTES = 147456;
static_assert(pg8::STAGE_BYTES <= RING_BYTES && attn_body::LDS_WS + 2048 <= RING_BYTES && MISC_OFF + 256 <= LDS_BYTES, "LDS map");

#define GAS __attribute__((address_space(1)))
#define LAS __attribute__((address_space(3)))
typedef unsigned short bfu;
typedef unsigned v4u __attribute__((ext_vector_type(4)));
typedef unsigned v2u __attribute__((ext_vector_type(2)));
typedef float f32x4 __attribute__((ext_vector_type(4)));
typedef short bf16x8 __attribute__((ext_vector_type(8)));
#define LDS_WAIT() asm volatile("s_waitcnt lgkmcnt(0)" ::: "memory")
__device__ __forceinline__ unsigned f2bf(float f) { unsigned u = __builtin_bit_cast(unsigned, f); return (u + 0x7fffu + ((u >> 16) & 1u)) >> 16; }
__device__ __forceinline__ unsigned pk2(float lo, float hi) { return pg8::cvt_pk_bf16(lo, hi); }
__device__ __forceinline__ float bflo(unsigned w) { return __builtin_bit_cast(float, w << 16); }
__device__ __forceinline__ float bfhi(unsigned w) { return __builtin_bit_cast(float, w & 0xffff0000u); }
__device__ __forceinline__ float wave_sum(float v) {
#pragma unroll
    for (int o = 1; o < 64; o <<= 1) v += __shfl_xor(v, o);
    return v;
}
__device__ __forceinline__ float fexp2(float x) { return __builtin_amdgcn_exp2f(x); }
__device__ __forceinline__ float frcp(float x) { return __builtin_amdgcn_rcpf(x); }
__device__ __forceinline__ float silu_f(float g) { return g * frcp(1.f + fexp2(-LOG2E * g)); }
__device__ __forceinline__ float gelu_tanh(float x) { const float z = 0.7978845608028654f * (x + 0.044715f * x * x * x); return x * frcp(1.f + fexp2(-2.f * LOG2E * z)); }
__device__ __forceinline__ float ret_log2gamma(int h) { return log2f(1.f - exp2f(-5.f - (float)h)); }

#define XB_TMO      128
#define XB_XCNT(j)  (256  + 64 * (j))
#define XB_XSUB(j)  (1280 + 64 * (j))
#define XB_XGEN(j)  (2304 + 64 * (j))
#define XB_TOP      3328
#define XB_TOPGEN   3392
#define XCD_BAR_WORDS 3456
#define XB_SPIN_CAP (1u << 18)

__device__ __forceinline__ unsigned xb_ld(unsigned* p)              { return __hip_atomic_load(p, __ATOMIC_RELAXED, __HIP_MEMORY_SCOPE_AGENT); }
__device__ __forceinline__ unsigned xb_add(unsigned* p, unsigned v) { return __hip_atomic_fetch_add(p, v, __ATOMIC_RELAXED, __HIP_MEMORY_SCOPE_AGENT); }
__device__ __forceinline__ unsigned xb_xcc_id() { return (unsigned)__builtin_amdgcn_s_getreg((3 << 11) | 20) & 0xFu; }
#define XB_SPIN(cond, bar) do { unsigned _sp = 0; while (cond) { __builtin_amdgcn_s_sleep(1); \
    if ((++_sp & 255u) == 0u) { if (xb_ld(&(bar)[XB_TMO])) break; if (_sp > XB_SPIN_CAP) { atomicAdd(&(bar)[XB_TMO], 1u); break; } } } } while (0)

struct XcdBarrier {
    unsigned* bar; unsigned x;
    volatile LAS unsigned* st;
};

__device__ __forceinline__ XcdBarrier xcd_barrier_post(unsigned* bar, volatile LAS unsigned* st) {
    XcdBarrier b; b.bar = bar; b.x = xb_xcc_id(); b.st = st;
    if (threadIdx.x == 0) (void)xb_add(&bar[XB_XCNT(b.x)], 1u);
    return b;
}
__device__ __forceinline__ void xcd_barrier_complete(unsigned* bar, unsigned x, unsigned& nloc, unsigned& nx) {
    const unsigned G = gridDim.x * gridDim.y * gridDim.z;
    unsigned sum, cnt, mine, sp = 0u;
    for (;;) {
        sum = 0u; cnt = 0u; mine = 0u;
#pragma unroll
        for (unsigned j = 0; j < 16; ++j) { const unsigned c = xb_ld(&bar[XB_XCNT(j)]); sum += c; cnt += (c > 0u) ? 1u : 0u; mine = (j == x) ? c : mine; }
        if (sum == G) break;
        __builtin_amdgcn_s_sleep(1);
        if ((++sp & 255u) == 0u) { if (xb_ld(&bar[XB_TMO])) break; if (sp > XB_SPIN_CAP) { atomicAdd(&bar[XB_TMO], 1u); break; } }
    }
    nloc = mine > 0u ? mine : 1u; nx = cnt > 0u ? cnt : 1u;
}

__device__ __forceinline__ void xcd_barrier(const XcdBarrier& b) {
    asm volatile("s_waitcnt vmcnt(0)" ::: "memory");
    __syncthreads();
    if (threadIdx.x == 0) {
        unsigned* bar = b.bar;
        __builtin_amdgcn_s_waitcnt(0);
        unsigned nloc = b.st[0], nx = b.st[1];
        if (nloc == 0u) { xcd_barrier_complete(bar, b.x, nloc, nx); b.st[0] = nloc; b.st[1] = nx; }
        const unsigned old = xb_add(&bar[XB_XSUB(b.x)], 1u);
        const unsigned gen = old / nloc;
        if (old + 1u == (gen + 1u) * nloc) {
            __builtin_amdgcn_fence(__ATOMIC_RELEASE, "agent");
            asm volatile("s_waitcnt vmcnt(0)" ::: "memory");
            const unsigned og = xb_add(&bar[XB_TOP], 1u);
            const unsigned tg = og / nx;
            if (og + 1u == (tg + 1u) * nx) xb_add(&bar[XB_TOPGEN], 1u);
            else XB_SPIN(xb_ld(&bar[XB_TOPGEN]) == tg, bar);
            __builtin_amdgcn_fence(__ATOMIC_ACQUIRE, "agent");
            xb_add(&bar[XB_XGEN(b.x)], 1u);
            asm volatile("s_waitcnt vmcnt(0)" ::: "memory");
        } else {
            XB_SPIN(xb_ld(&bar[XB_XGEN(b.x)]) == gen, bar);
            __builtin_amdgcn_fence(__ATOMIC_ACQUIRE, "agent");
            asm volatile("s_waitcnt vmcnt(0)" ::: "memory");
        }
    }
    __syncthreads();
}

struct Args { const float* in[20]; float* out; unsigned char* ws; int ph_lo, ph_hi; };
__device__ __forceinline__ const float* karg(int k) { int kk = k; asm volatile("" : "+s"(kk)); return ((const float* const __attribute__((address_space(4)))*)__builtin_amdgcn_kernarg_segment_ptr())[kk]; }

__device__ __forceinline__ void p0_transpose_item(const float* W, int K, int N, bfu* WT, int drow0, LAS float* scr, int k0, int n0, int lane, const float* gk) {
#pragma unroll 8
    for (int i = 0; i < 32; ++i) { const int kk = 2 * i + (lane >> 5); scr[kk * 33 + (lane & 31)] = __builtin_nontemporal_load(W + (size_t)(k0 + kk) * N + n0 + (lane & 31)); }
    LDS_WAIT(); asm volatile("" ::: "memory");
    const int c = lane & 7;
    f32x4 ga = (f32x4){1.f, 1.f, 1.f, 1.f}, gb = ga;
    if (gk) { ga = *(const f32x4*)(gk + k0 + 8 * c); gb = *(const f32x4*)(gk + k0 + 8 * c + 4); }
#pragma unroll
    for (int j = 0; j < 4; ++j) { const int n = (lane >> 3) + 8 * j; const LAS float* s = scr + (8 * c) * 33 + n;
        v4u o; o.x = pk2(s[0 * 33] * ga.x, s[1 * 33] * ga.y); o.y = pk2(s[2 * 33] * ga.z, s[3 * 33] * ga.w); o.z = pk2(s[4 * 33] * gb.x, s[5 * 33] * gb.y); o.w = pk2(s[6 * 33] * gb.z, s[7 * 33] * gb.w);
        *(v4u*)(WT + (size_t)(drow0 + n) * K + k0 + 8 * c) = o; }
    LDS_WAIT(); asm volatile("" ::: "memory");
}
__device__ __forceinline__ void xn_rows(const float* x, bfu* XB, float* RS, int gw, int NGW, int lane) {
    for (int m = gw; m < M; m += NGW) {
        const f32x4* xr = (const f32x4*)(x + (size_t)m * DM) + lane; f32x4 v[8]; float s = 0.f;
#pragma unroll
        for (int j = 0; j < 8; ++j) { v[j] = __builtin_nontemporal_load(xr + 64 * j); s += (v[j].x * v[j].x + v[j].y * v[j].y) + (v[j].z * v[j].z + v[j].w * v[j].w); }
        const float rstd = 1.f / sqrtf(wave_sum(s) * (1.f / DM) + EPS);
        v2u* o8 = (v2u*)(XB + (size_t)m * DM) + lane;
#pragma unroll
        for (int j = 0; j < 8; ++j) { v2u w; w.x = pk2(v[j].x, v[j].y); w.y = pk2(v[j].z, v[j].w); o8[64 * j] = w; }
        if (lane == 0) RS[m] = rstd;
    }
}
template <bool FINAL, bool DUMMY = false> __device__ __forceinline__ void norm_rows(const bfu* F, bfu* XB, const float* g1, float* RS, float* xout, int gw, int NGW, int lane, bfu* dummy = nullptr) {
    int m = gw; if (m >= M) return;
    v2u fw[8], xw[8];
#pragma unroll
    for (int j = 0; j < 8; ++j) { fw[j] = __builtin_nontemporal_load((const v2u*)(F + (size_t)m * DM) + lane + 64 * j); xw[j] = ((const v2u*)(XB + (size_t)m * DM) + lane)[64 * j]; }
    for (; m < M; m += NGW) {
        f32x4 f[8], x[8]; float s = 0.f;
#pragma unroll
        for (int j = 0; j < 8; ++j) { f[j] = (f32x4){bflo(fw[j].x), bfhi(fw[j].x), bflo(fw[j].y), bfhi(fw[j].y)}; x[j] = (f32x4){bflo(xw[j].x), bfhi(xw[j].x), bflo(xw[j].y), bfhi(xw[j].y)}; }
        const int mn = m + NGW;
        if (mn < M) {
#pragma unroll
            for (int j = 0; j < 8; ++j) { fw[j] = __builtin_nontemporal_load((const v2u*)(F + (size_t)mn * DM) + lane + 64 * j); xw[j] = ((const v2u*)(XB + (size_t)mn * DM) + lane)[64 * j]; }
        }
#pragma unroll
        for (int j = 0; j < 8; ++j) s += (f[j].x * f[j].x + f[j].y * f[j].y) + (f[j].z * f[j].z + f[j].w * f[j].w);
        const float rstd1 = 1.f / sqrtf(wave_sum(s) * (1.f / DM) + EPS);
        float s2 = 0.f;
#pragma unroll
        for (int j = 0; j < 8; ++j) { const f32x4 gg = ((const f32x4*)g1)[lane + 64 * j]; x[j] = x[j] + f[j] * rstd1 * gg; s2 += (x[j].x * x[j].x + x[j].y * x[j].y) + (x[j].z * x[j].z + x[j].w * x[j].w); }
        if (FINAL) { f32x4* xo = (f32x4*)(xout + (size_t)m * DM) + lane;
#pragma unroll
            for (int j = 0; j < 8; ++j) xo[64 * j] = x[j];
        } else {
            v2u* xr = (v2u*)((DUMMY ? dummy : XB) + (size_t)m * DM) + lane;
#pragma unroll
            for (int j = 0; j < 8; ++j) { v2u w; w.x = pk2(x[j].x, x[j].y); w.y = pk2(x[j].z, x[j].w); xr[64 * j] = w; }
            const float rstd2 = 1.f / sqrtf(wave_sum(s2) * (1.f / DM) + EPS);
            if (lane == 0) (DUMMY ? (float*)dummy + (size_t)M * DM : RS)[m] = rstd2;
        }
    }
}

__device__ __forceinline__ void stage_nat(LAS bfu* dst, const bfu* src, int pitch, int tid) {
#pragma unroll
    for (int i = 0; i < 4; ++i) { const int id = tid + NTHR * i, r = id >> 4, ch = id & 15; const v4u v = *(const v4u*)(src + (size_t)r * pitch + ch * 8); *(LAS v4u*)(dst + r * TS + ch * 8) = v; }
}
template <bool SC> __device__ __forceinline__ void stage_tr(LAS bfu* dst, const bfu* src, int pitch, int tid, float lg) {
#pragma unroll
    for (int i = 0; i < 4; ++i) { const int id = tid + NTHR * i, c = id & 127, ch = id >> 7; const v4u v = *(const v4u*)(src + (size_t)c * pitch + ch * 8);
        const float sc = SC ? fexp2(lg * (float)(127 - c)) : 1.f;
#pragma unroll
        for (int j = 0; j < 4; ++j) { unsigned w = v[j];
            if (SC) w = pk2(bflo(w) * sc, bfhi(w) * sc);
            dst[(ch * 8 + 2 * j) * TS + c] = (bfu)(w & 0xffffu); dst[(ch * 8 + 2 * j + 1) * TS + c] = (bfu)(w >> 16); } }
}
__device__ __forceinline__ void wave_mma(f32x4 (&acc)[8], const LAS bfu* As, const LAS bfu* Bs, int m0, int fr, int fq) {
#pragma unroll
    for (int ks = 0; ks < 4; ++ks) { const bf16x8 a = *(const LAS bf16x8*)(As + (m0 + fr) * TS + ks * 32 + fq * 8);
#pragma unroll
        for (int t = 0; t < 8; ++t) { const bf16x8 b = *(const LAS bf16x8*)(Bs + (t * 16 + fr) * TS + ks * 32 + fq * 8); acc[t] = __builtin_amdgcn_mfma_f32_16x16x32_bf16(b, a, acc[t], 0, 0, 0); } }
}
#define ZERO8(a) do { _Pragma("unroll") for (int t_ = 0; t_ < 8; ++t_) a[t_] = (f32x4){0.f, 0.f, 0.f, 0.f}; } while (0)

#ifndef PG8ALIGN
#define PG8ALIGN true
#endif
#ifndef PG8SP2
#define PG8SP2 true
#endif
#ifndef XSKIP
#define XSKIP 1
#endif
#ifndef XTAIL
#define XTAIL 0
#endif
#ifndef ATT_THRL
#define ATT_THRL 80
#endif
constexpr int Q_SCAN = 768, Q_ATT = Q_SCAN + 96, Q_RET = Q_ATT + 768, Q_SGU = Q_RET + 768, Q_END = Q_SGU + 512;
__device__ __forceinline__ void st_sc1_u2(void* p, unsigned lo, unsigned hi) { __hip_atomic_store((GAS unsigned long long*)p, ((unsigned long long)hi << 32) | (unsigned long long)lo, __ATOMIC_RELAXED, __HIP_MEMORY_SCOPE_AGENT); }
__device__ __forceinline__ void st_sc1_x4(float* p, f32x4 v) { st_sc1_u2(p, __float_as_uint(v[0]), __float_as_uint(v[1])); st_sc1_u2(p + 2, __float_as_uint(v[2]), __float_as_uint(v[3])); }
__device__ __forceinline__ void publish(unsigned* word) {
    asm volatile("s_waitcnt vmcnt(0)" ::: "memory"); __syncthreads();
    if (threadIdx.x == 0) __hip_atomic_fetch_add(word, 1u, __ATOMIC_RELAXED, __HIP_MEMORY_SCOPE_AGENT);
}
__device__ __forceinline__ void publish_release(unsigned* word) {
    asm volatile("s_waitcnt vmcnt(0)" ::: "memory"); __syncthreads();
    if (threadIdx.x == 0) { __builtin_amdgcn_fence(__ATOMIC_RELEASE, "agent"); asm volatile("s_waitcnt vmcnt(0)" ::: "memory"); __hip_atomic_fetch_add(word, 1u, __ATOMIC_RELAXED, __HIP_MEMORY_SCOPE_AGENT); }
}
__device__ __forceinline__ void wait_ge(unsigned* word, unsigned want, unsigned* tmo) {
    if (threadIdx.x == 0) {
        unsigned sp = 0;
        while (__hip_atomic_load(word, __ATOMIC_RELAXED, __HIP_MEMORY_SCOPE_AGENT) < want) {
            __builtin_amdgcn_s_sleep(2);
            if (++sp > (1u << 21)) { __hip_atomic_store(tmo, 1u, __ATOMIC_RELAXED, __HIP_MEMORY_SCOPE_AGENT); break; }
            if ((sp & 1023u) == 0u && __hip_atomic_load(tmo, __ATOMIC_RELAXED, __HIP_MEMORY_SCOPE_AGENT)) break;
        }
        __builtin_amdgcn_fence(__ATOMIC_ACQUIRE, "agent");
        asm volatile("s_waitcnt vmcnt(0)" ::: "memory");
    }
    __syncthreads();
}
__device__ __forceinline__ void qk_norms(LAS unsigned char* lds, const bfu* PROJ, unsigned* nw) {
    int tid = threadIdx.x; asm volatile("" : "+v"(tid)); const int lane = tid & 63, wid = __builtin_amdgcn_readfirstlane(tid >> 6);
    const int gw = blockIdx.x * NWAVES + wid, NGW = gridDim.x * NWAVES;
    float m0[3] = {0.f, 0.f, 0.f}, m1[3] = {0.f, 0.f, 0.f};
    for (int mb = gw; mb < M; mb += 4 * NGW) {
        v4u w[4][3];
#pragma unroll
        for (int r = 0; r < 4; ++r) { const int m = mb + r * NGW; const bfu* rp = PROJ + (size_t)(m < M ? m : mb) * INW + C_DQ + lane * 8;
#pragma unroll
            for (int ld = 0; ld < 3; ++ld) w[r][ld] = *(const v4u*)(rp + ld * 512); }
#pragma unroll
        for (int r = 0; r < 4; ++r) { const int m = mb + r * NGW; if (m >= M) break; float s[3];
#pragma unroll
            for (int ld = 0; ld < 3; ++ld) { float a = 0.f;
#pragma unroll
                for (int j = 0; j < 4; ++j) { const float lo = bflo(w[r][ld][j]), hi = bfhi(w[r][ld][j]); a += lo * lo + hi * hi; }
                a += __shfl_xor(a, 1); a += __shfl_xor(a, 2); a += __shfl_xor(a, 4); s[ld] = a; }
            if (m >= SEQ) { m1[0] = fmaxf(m1[0], s[0]); m1[1] = fmaxf(m1[1], s[1]); m1[2] = fmaxf(m1[2], s[2]); }
            else          { m0[0] = fmaxf(m0[0], s[0]); m0[1] = fmaxf(m0[1], s[1]); m0[2] = fmaxf(m0[2], s[2]); } }
    }
    LAS float* red = (LAS float*)lds;
    if ((lane & 7) == 0) {
#pragma unroll
        for (int ld = 0; ld < 3; ++ld) { red[wid * 48 + ld * 8 + (lane >> 3)] = m0[ld]; red[wid * 48 + 24 + ld * 8 + (lane >> 3)] = m1[ld]; } }
    __syncthreads();
    if (tid < 48) { float v = red[tid];
#pragma unroll
        for (int w = 1; w < 8; ++w) v = fmaxf(v, red[w * 48 + tid]);
        const unsigned old = __hip_atomic_fetch_max(nw + tid, __float_as_uint(v), __ATOMIC_RELAXED, __HIP_MEMORY_SCOPE_AGENT); asm volatile("" :: "v"(old)); }
}
struct AttnOrder { unsigned char u[2][96]; };
constexpr AttnOrder make_attn_order() {
    AttnOrder o{}; const int win[6] = {12, 20, 40, 96, 999, 999}; const int hd[2][3] = {{0, 3, 5}, {1, 2, 4}};
    for (int ty = 0; ty < 2; ++ty) { int cost[96] = {}; int id[96] = {}; int n = 0;
        for (int qb = 31; qb >= 0; --qb) for (int sl = 0; sl < 3; ++sl) { const int w = win[hd[ty][sl]], c = (4 * qb + 4 < w) ? 4 * qb + 4 : w; cost[n] = c; id[n] = (sl << 5) | qb; ++n; }
        for (int i = 1; i < 96; ++i) { const int c = cost[i], v = id[i]; int j = i - 1; while (j >= 0 && cost[j] < c) { cost[j + 1] = cost[j]; id[j + 1] = id[j]; --j; } cost[j + 1] = c; id[j + 1] = v; }
        for (int i = 0; i < 96; ++i) o.u[ty][i] = (unsigned char)id[i]; }
    return o;
}
__device__ const AttnOrder ATTN_ORDER = make_attn_order();
__device__ __forceinline__ void kv_unit(LAS unsigned char* lds, const bfu* PROJ, float* KVT, int u) {
    int tid = threadIdx.x; asm volatile("" : "+v"(tid)); const int lane = tid & 63, wid = __builtin_amdgcn_readfirstlane(tid >> 6); (void)lane; (void)wid;
    const int bh = u >> 6, i = u & 63, b = bh / 6, h = bh % 6; const size_t row0 = (size_t)b * SEQ + (size_t)i * 128; const float lg = ret_log2gamma(h);
    LAS bfu* Vt = (LAS bfu*)lds; LAS bfu* Kt = (LAS bfu*)(lds + TILE_B);
    stage_tr<false>(Vt, PROJ + row0 * INW + C_RV + h * 128, INW, tid, 0.f);
    stage_tr<true>(Kt, PROJ + row0 * INW + C_RK + h * 128, INW, tid, lg);
    __syncthreads();
    const int fr = lane & 15, fq = lane >> 4, m0 = wid * 16; f32x4 acc[8]; ZERO8(acc);
    wave_mma(acc, Vt, Kt, m0, fr, fq);
    float* o = KVT + (size_t)u * 16384 + (m0 + fr) * 128 + 4 * fq;
#pragma unroll
    for (int t = 0; t < 8; ++t) st_sc1_x4(o + 16 * t, acc[t]);
}
__device__ __forceinline__ void scan_unit(const float* KVT, bfu* RT, int s) {
    int tid = threadIdx.x; asm volatile("" : "+v"(tid)); const int lane = tid & 63, wid = __builtin_amdgcn_readfirstlane(tid >> 6); (void)lane; (void)wid;
    const int bh = s >> 3, part = s & 7, h = bh % 6; const float G = exp2f(ret_log2gamma(h) * 128.f);
    const size_t e = (size_t)bh * 64 * 16384 + part * 2048 + tid * 4; f32x4 st = (f32x4){0.f, 0.f, 0.f, 0.f};
#pragma unroll 8
    for (int i = 0; i < 64; ++i) { const f32x4 cur = *(const f32x4*)(KVT + e + (size_t)i * 16384); st_sc1_u2(RT + e + (size_t)i * 16384, pk2(st[0], st[1]), pk2(st[2], st[3])); st = cur + st * G; }
}
__device__ __forceinline__ void ret_unit(LAS unsigned char* lds, const bfu* PROJ, const bfu* RT, const float* gn_g, bfu* CAT, int u) {
    int tid = threadIdx.x; asm volatile("" : "+v"(tid)); const int lane = tid & 63, wid = __builtin_amdgcn_readfirstlane(tid >> 6); (void)lane; (void)wid;
    const int bh = u >> 6, i = u & 63, b = bh / 6, h = bh % 6; const size_t row0 = (size_t)b * SEQ + (size_t)i * 128; const float lg = ret_log2gamma(h);
    LAS bfu* Qs = (LAS bfu*)lds; LAS bfu* Ks = (LAS bfu*)(lds + TILE_B); LAS bfu* Vt = (LAS bfu*)(lds + 2 * TILE_B); LAS bfu* Rt = (LAS bfu*)(lds + 3 * TILE_B);
    const bfu* P0 = PROJ + row0 * INW + h * 128;
    stage_nat(Qs, P0 + C_RQ, INW, tid); stage_nat(Ks, P0 + C_RK, INW, tid); stage_tr<false>(Vt, P0 + C_RV, INW, tid, 0.f); stage_nat(Rt, RT + (size_t)u * 16384, 128, tid);
    __syncthreads();
    const int fr = lane & 15, fq = lane >> 4, m0 = wid * 16, c = m0 + fr;
    f32x4 acc[8], cr[8]; ZERO8(acc); ZERO8(cr);
    wave_mma(cr, Qs, Rt, m0, fr, fq);
    wave_mma(acc, Qs, Ks, m0, fr, fq);
    __syncthreads();
#pragma unroll
    for (int t = 0; t < 8; ++t) { float p[4];
#pragma unroll
        for (int j = 0; j < 4; ++j) { const int e = 16 * t + 4 * fq + j; p[j] = (c >= e) ? acc[t][j] * fexp2(lg * (float)(c - e)) : 0.f; }
        v2u w; w.x = pk2(p[0], p[1]); w.y = pk2(p[2], p[3]); *(LAS v2u*)(Ks + c * TS + 16 * t + 4 * fq) = w; }
    LDS_WAIT(); asm volatile("" ::: "memory");
    ZERO8(acc);
    wave_mma(acc, Ks, Vt, m0, fr, fq);
    const float xi = fexp2(lg * (float)(c + 1)); float s = 0.f;
#pragma unroll
    for (int t = 0; t < 8; ++t) { acc[t] = acc[t] + cr[t] * xi; s += (acc[t][0] + acc[t][1]) + (acc[t][2] + acc[t][3]); }
    s += __shfl_xor(s, 16); s += __shfl_xor(s, 32); const float mu = s * (1.f / 128.f); float q = 0.f;
#pragma unroll
    for (int t = 0; t < 8; ++t) { acc[t] = acc[t] - mu; q += (acc[t][0] * acc[t][0] + acc[t][1] * acc[t][1]) + (acc[t][2] * acc[t][2] + acc[t][3] * acc[t][3]); }
    q += __shfl_xor(q, 16); q += __shfl_xor(q, 32); const float rstd = 1.f / sqrtf(q * (1.f / 128.f) + EPS);
    const bfu* gp = P0 + (size_t)c * INW + C_RG + 4 * fq; bfu* op = CAT + (row0 + c) * DM + h * 128 + 4 * fq; const float* gg = gn_g + h * 128 + 4 * fq;
#pragma unroll
    for (int t = 0; t < 8; ++t) { const v2u gw = *(const v2u*)(gp + 16 * t); const f32x4 g4 = *(const f32x4*)(gg + 16 * t);
        const float o0 = silu_f(bflo(gw.x)) * acc[t][0] * rstd * g4.x, o1 = silu_f(bfhi(gw.x)) * acc[t][1] * rstd * g4.y, o2 = silu_f(bflo(gw.y)) * acc[t][2] * rstd * g4.z, o3 = silu_f(bfhi(gw.y)) * acc[t][3] * rstd * g4.w;
        v2u w; w.x = pk2(o0, o1); w.y = pk2(o2, o3); *(v2u*)(op + 16 * t) = w; }
    __syncthreads();
}
__device__ __forceinline__ void sgu_unit(LAS unsigned char* lds, const bfu* PROJ, const bfu* SW  , const float* ln_g, const float* ln_b, const float* sb, bfu* CAT, int s) {
    int tid = threadIdx.x; asm volatile("" : "+v"(tid)); const int lane = tid & 63, wid = __builtin_amdgcn_readfirstlane(tid >> 6); (void)lane; (void)wid;
    const int chunk = s >> 2, g = s & 3; const size_t row0 = (size_t)chunk * 128;
    LAS bfu* Ws = (LAS bfu*)lds; LAS bfu* Vt = (LAS bfu*)(lds + TILE_B); LAS float* red = (LAS float*)(lds + 2 * TILE_B);
    stage_nat(Ws, SW + (size_t)g * 16384, 128, tid);
    const int sr = tid & 127, qd = tid >> 7;
    const bfu* vp = PROJ + (row0 + sr) * INW + C_SV + g * 128 + qd * 32; float v[32]; float a = 0.f, a2 = 0.f;
#pragma unroll
    for (int k = 0; k < 4; ++k) { const v4u w = *(const v4u*)(vp + 8 * k);
#pragma unroll
        for (int j = 0; j < 4; ++j) { const float x0 = gelu_tanh(bflo(w[j])), x1 = gelu_tanh(bfhi(w[j])); v[8 * k + 2 * j] = x0; v[8 * k + 2 * j + 1] = x1; a += x0 + x1; a2 += x0 * x0 + x1 * x1; } }
    red[qd * 128 + sr] = a; red[512 + qd * 128 + sr] = a2;
    __syncthreads();
    { const float sm = (red[sr] + red[128 + sr]) + (red[256 + sr] + red[384 + sr]), sq = (red[512 + sr] + red[640 + sr]) + (red[768 + sr] + red[896 + sr]);
      const float mu = sm * (1.f / 128.f), var = fmaxf(sq * (1.f / 128.f) - mu * mu, 0.f), rstd = 1.f / sqrtf(var + EPS);
      const float* lg_ = ln_g + g * 128 + qd * 32; const float* lb_ = ln_b + g * 128 + qd * 32;
#pragma unroll
      for (int k = 0; k < 32; ++k) Vt[(qd * 32 + k) * TS + sr] = (bfu)f2bf((v[k] - mu) * rstd * lg_[k] + lb_[k]); }
    __syncthreads();
    const int fr = lane & 15, fq = lane >> 4, m0 = wid * 16, t_ = m0 + fr; f32x4 acc[8]; ZERO8(acc);
    wave_mma(acc, Ws, Vt, m0, fr, fq);
    const float bias = sb[g * 128 + t_];
    const bfu* up = PROJ + (row0 + t_) * INW + C_SU + g * 128 + 4 * fq; bfu* op = CAT + (row0 + t_) * DM + 1536 + g * 128 + 4 * fq;
#pragma unroll
    for (int t = 0; t < 8; ++t) { const v2u uw = *(const v2u*)(up + 16 * t);
        v2u w; w.x = pk2(gelu_tanh(bflo(uw.x)) * (acc[t][0] + bias), gelu_tanh(bfhi(uw.x)) * (acc[t][1] + bias)); w.y = pk2(gelu_tanh(bflo(uw.y)) * (acc[t][2] + bias), gelu_tanh(bfhi(uw.y)) * (acc[t][3] + bias));
        *(v2u*)(op + 16 * t) = w; }
    __syncthreads();
}
__device__ __forceinline__ void diff_final(const bfu* D0, const bfu* D1, float lam, const float* sg, float omli, bfu* CAT, int gw, int NGW, int lane) {
    const int half = lane >> 5, l32 = lane & 31;
    for (int it = gw * 2 + half; it < M * 6; it += NGW * 2) { const int row = it / 6, h = it - row * 6;
        const v2u a_ = __builtin_nontemporal_load((const v2u*)(D0 + (size_t)row * 768 + h * 128 + l32 * 4)), b_ = __builtin_nontemporal_load((const v2u*)(D1 + (size_t)row * 768 + h * 128 + l32 * 4));
        const f32x4 v = (f32x4){bflo(a_.x), bfhi(a_.x), bflo(a_.y), bfhi(a_.y)} - (f32x4){bflo(b_.x), bfhi(b_.x), bflo(b_.y), bfhi(b_.y)} * lam; float s = (v.x * v.x + v.y * v.y) + (v.z * v.z + v.w * v.w);
#pragma unroll
        for (int o = 1; o < 32; o <<= 1) s += __shfl_xor(s, o);
        const float r = omli / sqrtf(s * (1.f / 128.f) + EPS); const f32x4 g4 = *(const f32x4*)(sg + h * 128 + l32 * 4);
        v2u w; w.x = pk2(v.x * r * g4.x, v.y * r * g4.y); w.y = pk2(v.z * r * g4.z, v.w * r * g4.w); *(v2u*)(CAT + (size_t)row * DM + 768 + h * 128 + l32 * 4) = w; }
}

__global__ void __launch_bounds__(NTHR, 2) fwd(Args args) {
    extern __shared__ __attribute__((aligned(16))) unsigned char lds_raw[];
    LAS unsigned char* lds = (LAS unsigned char*)lds_raw;
    volatile LAS int* MISC = (volatile LAS int*)(lds + MISC_OFF);
    const int G = gridDim.x, NGW = G * NWAVES;
#define PIN_TID() int tid = threadIdx.x; asm volatile("" : "+v"(tid)); const int lane = tid & 63, wid = __builtin_amdgcn_readfirstlane(tid >> 6), gw = blockIdx.x * NWAVES + wid; (void)lane; (void)gw
#define WSB ((unsigned char*)karg(21))
#define ctl ((unsigned*)(WSB + WS_CTL))
#define SGUW ((bfu*)(WSB + WS_SGUW))
#define WIN ((bfu*)(WSB + WS_WIN))
#define WOUT ((bfu*)(WSB + WS_WOUT))
#define WGU ((bfu*)(WSB + WS_WGU))
#define WDN ((bfu*)(WSB + WS_WDN))
#define XN ((bfu*)(WSB + WS_XN))
#define PROJ ((bfu*)(WSB + WS_PROJ))
#define HID ((bfu*)(WSB + WS_HID))
#define CAT ((bfu*)(WSB + WS_CAT))
#define F32 ((bfu*)(WSB + WS_F32))
#define DIFF ((bfu*)(WSB + WS_DIFF))
#define DIFF1 ((bfu*)(WSB + WS_DIFF1))
#define KVT ((float*)(WSB + WS_KVT))
#define RT ((bfu*)(WSB + WS_RT))
#define RS ((float*)(WSB + WS_RS))
#define x_in karg(0)
#define out ((float*)karg(20))
    const int lo = args.ph_lo, hi = args.ph_hi;
    if (threadIdx.x < 64) MISC[threadIdx.x] = 0;
    __syncthreads();
    XcdBarrier bar = xcd_barrier_post(ctl + CW_BAR, (volatile LAS unsigned*)(MISC + 8));
    int ph = 0;
    if (lo < 0) cg::this_grid().sync();
#ifndef X_MASK
#define X_MASK 1023
#endif
#define XEN(k) (((X_MASK) >> (k)) & 1)
#ifndef X_REPMASK
#define X_REPMASK 0
#endif
#define XREP(k) (1 + (((X_REPMASK) >> (k)) & 1))
#define IN_PH() (lo <= ph && ph < hi)
#define SEAM() do { if (lo <= ph && ph + 1 < hi) { xcd_barrier(bar); if (XREP(10) > 1) xcd_barrier(bar); } ++ph; } while (0)

    if (XEN(0) && IN_PH()) for (int rep = 0; rep < XREP(0); ++rep) { PIN_TID();
        LAS float* scr = (LAS float*)(lds + wid * 16384);
        constexpr int I_IN = 32 * 200, I_OUT = 32 * 64, I_G = 32 * 176, I_D = 88 * 64, I_L = I_IN + I_OUT + 2 * I_G + I_D;
        for (int it = gw; it < DEPTH * I_L; it += NGW) {
            const int l = it / I_L; int r = it - l * I_L;
            if (r < I_IN) { const int kb = r / 200, nb = r % 200; p0_transpose_item(karg(2) + (size_t)l * DM * INW, DM, INW, WIN + (size_t)l * INW * DM, 32 * nb, scr, 64 * kb, 32 * nb, lane, karg(1) + l * DM); continue; } r -= I_IN;
            if (r < I_OUT) { const int kb = r / 64, nb = r % 64; p0_transpose_item(karg(13) + (size_t)l * DM * DM, DM, DM, WOUT + (size_t)l * DM * DM, 32 * nb, scr, 64 * kb, 32 * nb, lane, nullptr); continue; } r -= I_OUT;
            if (r < I_G) { const int kb = r / 176, nb = r % 176, n0 = 32 * nb; p0_transpose_item(karg(16) + (size_t)l * DM * FFH, DM, FFH, WGU + (size_t)l * NGU * DM, (n0 >> 7) * 256 + (n0 & 127), scr, 64 * kb, n0, lane, karg(15) + l * DM); continue; } r -= I_G;
            if (r < I_G) { const int kb = r / 176, nb = r % 176, n0 = 32 * nb; p0_transpose_item(karg(17) + (size_t)l * DM * FFH, DM, FFH, WGU + (size_t)l * NGU * DM, (n0 >> 7) * 256 + 128 + (n0 & 127), scr, 64 * kb, n0, lane, karg(15) + l * DM); continue; } r -= I_G;
            { const int kb = r / 64, nb = r % 64; p0_transpose_item(karg(18) + (size_t)l * FFH * DM, FFH, DM, WDN + (size_t)l * DM * FFH, 32 * nb, scr, 64 * kb, 32 * nb, lane, nullptr); }
        }
        for (int e = blockIdx.x * NTHR + tid; e < DEPTH * 4 * 128 * 128; e += G * NTHR) { const int s_ = e & 127, t_ = (e >> 7) & 127; SGUW[e] = (bfu)f2bf(s_ <= t_ ? karg(11)[e] : 0.f); }
        xn_rows(x_in, XN, RS, gw, NGW, lane);
        __syncthreads();
    }
    SEAM();

    for (int l = 0; l < DEPTH; ++l) {
#define lambda_init (0.8f - 0.6f * expf(-0.3f * (float)l))
        if (XEN(1) && IN_PH()) for (int rep = 0; rep < XREP(1); ++rep) { PIN_TID();
            pg8::Gemm g{XN, WIN + (size_t)l * INW * DM, M, INW, DM}; pg8::StaticOrder S; S.init(M, INW - 256 * XTAIL, G, (int)blockIdx.x);
            pg8::EpiProj E{PROJ, INW, RS};
            pg8::gemm_phase<pg8::EpiProj, pg8::StaticOrder, PG8ALIGN, PG8SP2>(lds, g, S, E);
        }
        SEAM();
        if (XEN(3) && IN_PH()) for (int rep = 0; rep < XREP(3); ++rep) { PIN_TID();
            unsigned* cw = ctl + CW_QUEUE + 1024 * l + 32 * rep;
#define PULL_ISSUE(hd) ((tid == 0) ? (int)__hip_atomic_fetch_add((hd), 1u, __ATOMIC_RELAXED, __HIP_MEMORY_SCOPE_AGENT) : 0)
#define BCAST(v) ({ if (tid == 0) MISC[0] = (v); __syncthreads(); const int u__ = __builtin_amdgcn_readfirstlane(MISC[0]); __syncthreads(); u__; })
            qk_norms(lds, PROJ, cw + 64 * 15); publish(cw + 64 * 14);
            { int nx = PULL_ISSUE(cw);
              for (;;) {
                const int u = BCAST(nx);
                if (u >= 768 + 96) break;
                nx = PULL_ISSUE(cw);
                if (u < 768) { kv_unit(lds, PROJ, KVT, u); publish(cw + 64 + (u >> 6)); }
                else { const int s_ = u - 768; wait_ge(cw + 64 + (s_ >> 3), 64u, cw + 192); scan_unit(KVT, RT, s_); publish(cw + 128 + (s_ >> 3)); }
              } }
#ifndef X_NO_ATTN
            wait_ge(cw + 64 * 14, (unsigned)G, cw + 192);
            { const int myx = (int)(xb_xcc_id() & 7u);
              unsigned stealmask = 1u;
              for (int k = 0; k < 8; ++k) { if (!((stealmask >> k) & 1u)) continue;
                const int x = (myx + k) & 7; unsigned* hd = cw + 64 * (4 + x);
                for (;;) {
                    const int j = BCAST(PULL_ISSUE(hd));
                    if (j >= 96) break;
                    const int ou_ = __builtin_amdgcn_readfirstlane((int)ATTN_ORDER.u[x < 4 ? 0 : 1][j]), qb = ou_ & 31, sl_ = ou_ >> 5, b = (x & 3) >> 1, mp = x & 1, h = (x < 4) ? (sl_ == 0 ? 0 : (sl_ == 1 ? 3 : 5)) : (sl_ == 0 ? 1 : (sl_ == 1 ? 2 : 4));
                    const float cs = __builtin_bit_cast(float, __builtin_amdgcn_readfirstlane(__builtin_bit_cast(int, exp2f(-8.f * (float)(h + 1) / 6.f) * LOG2E)));
                    const attn_body::bf16* Pj = (const attn_body::bf16*)PROJ; float* Dg = (float*)((mp ? DIFF1 : DIFF) + h * 128);
                    int t0 = 0;
                    { const unsigned* nwp = cw + 64 * 15 + b * 24 + h * 2 + mp;
                      const float nq = __uint_as_float(__hip_atomic_load(nwp, __ATOMIC_RELAXED, __HIP_MEMORY_SCOPE_AGENT)), nk = __uint_as_float(__hip_atomic_load(nwp + 12, __ATOMIC_RELAXED, __HIP_MEMORY_SCOPE_AGENT));
                      const float Bq = sqrtf(nq * nk) * 1.01f + 0.01f, lim = 256.f * (float)qb - 63.f - (2.f * Bq + 160.f) / cs;
                      if (lim >= 0.f) { const int tmax = (int)floorf(lim * (1.f / 64.f)); t0 = (tmax + 1) & ~1; if (t0 > 4 * qb) t0 = 4 * qb; }
                      t0 = __builtin_amdgcn_readfirstlane(t0); }
                    attn_body::attn_unit<ATT_THRL>(b, qb, XSKIP ? t0 : 0, Pj + C_DQ + h * 128 + 64 * mp, Pj + C_DK + h * 128 + 64 * mp, Pj + C_DV + h * 128, Dg, cs, 0.f, (char*)lds_raw);
                }
                if (k == 0) {
                    int av = 0;
                    if (tid < 8) av = (tid > 0 && __hip_atomic_load(cw + 64 * (4 + ((myx + tid) & 7)), __ATOMIC_RELAXED, __HIP_MEMORY_SCOPE_AGENT) < 96u) ? (1 << tid) : 0;
                    if (tid < 8) { av |= __shfl_xor(av, 1); av |= __shfl_xor(av, 2); av |= __shfl_xor(av, 4); }
                    stealmask = (unsigned)BCAST(av);
                }
              } }
#endif
            { int nx = PULL_ISSUE(cw + 64 * 12);
              for (;;) {
                const int u = BCAST(nx);
                if (u >= 768 + 512) break;
                nx = PULL_ISSUE(cw + 64 * 12);
                if (u < 768) { wait_ge(cw + 128 + (u >> 6), 8u, cw + 192); ret_unit(lds, PROJ, RT, karg(3) + l * 768, CAT, u); }
                else sgu_unit(lds, PROJ, SGUW + (size_t)l * 65536, karg(9) + l * 512, karg(10) + l * 512, karg(12) + l * 512, CAT, u - 768);
              } }
#undef PULL_ISSUE
#undef BCAST
        }
        SEAM();
        if (XEN(4) && IN_PH()) for (int rep = 0; rep < XREP(4); ++rep) { PIN_TID();
            float lam;
            { const float a = (lane < 64) ? karg(4)[l * 64 + lane] * karg(5)[l * 64 + lane] : 0.f, b_ = karg(6)[l * 64 + lane] * karg(7)[l * 64 + lane];
              lam = expf(wave_sum(a)) - expf(wave_sum(b_)) + lambda_init; lam = __builtin_bit_cast(float, __builtin_amdgcn_readfirstlane(__builtin_bit_cast(int, lam))); }
            diff_final(DIFF, DIFF1, lam, karg(8) + l * 768, 1.f - lambda_init, CAT, gw, NGW, lane);
        }
        SEAM();
        if (XEN(5) && IN_PH()) for (int rep = 0; rep < XREP(5); ++rep) { PIN_TID();
            pg8::Gemm g{CAT, WOUT + (size_t)l * DM * DM, M, DM, DM}; pg8::StaticOrder S; S.init(M, DM, G, (int)blockIdx.x);
            pg8::EpiBf E{F32, DM};
            pg8::gemm_phase<pg8::EpiBf, pg8::StaticOrder, PG8ALIGN, PG8SP2>(lds, g, S, E);
        }
        SEAM();
        if (XEN(6) && IN_PH()) for (int rep = 0; rep < XREP(6); ++rep) { PIN_TID(); if (XREP(6) > 1 && rep == 0) norm_rows<false, true>(F32, XN, karg(14) + l * DM, RS, nullptr, gw, NGW, lane, PROJ); else norm_rows<false>(F32, XN, karg(14) + l * DM, RS, nullptr, gw, NGW, lane); }
        SEAM();
        if (XEN(7) && IN_PH()) for (int rep = 0; rep < XREP(7); ++rep) { PIN_TID();
            pg8::Gemm g{XN, WGU + (size_t)l * NGU * DM, M, NGU, DM}; pg8::StaticOrder S; S.init(M, NGU, G, (int)blockIdx.x);
            pg8::EpiSwiGLU E{HID, FFH, RS};
            pg8::gemm_phase<pg8::EpiSwiGLU, pg8::StaticOrder, PG8ALIGN, PG8SP2>(lds, g, S, E);
        }
        SEAM();
        if (XEN(8) && IN_PH()) for (int rep = 0; rep < XREP(8); ++rep) { PIN_TID();
            pg8::Gemm g{HID, WDN + (size_t)l * DM * FFH, M, DM, FFH}; pg8::StaticOrder S; S.init(M, DM, G, (int)blockIdx.x);
            pg8::EpiBf E{F32, DM};
            pg8::gemm_phase<pg8::EpiBf, pg8::StaticOrder, PG8ALIGN, PG8SP2>(lds, g, S, E);
        }
        SEAM();
        if (XEN(9) && IN_PH()) for (int rep = 0; rep < XREP(9); ++rep) { PIN_TID(); if (XREP(9) > 1 && rep == 0) norm_rows<false, true>(F32, XN, karg(19) + l * DM, RS, nullptr, gw, NGW, lane, PROJ); else if (l + 1 < DEPTH) norm_rows<false>(F32, XN, karg(19) + l * DM, RS, nullptr, gw, NGW, lane); else norm_rows<true>(F32, XN, karg(19) + l * DM, nullptr, out, gw, NGW, lane); }
        SEAM();
    }
}
#undef lambda_init
#undef out
#undef x_in
#undef ctl
constexpr int N_PHASES = 1 + 8 * DEPTH;

extern "C" void kernel_launch(void* const* d_in, const int* in_sizes, int n_in, void* d_out, int out_size, void* d_ws, size_t ws_size, hipStream_t stream) {
    static int grid = 0;
    if (grid == 0) {
        if (n_in != 20 || in_sizes[0] != M * DM || out_size != M * DM || ws_size < WS_END) { fprintf(stderr, "kernel_launch: unexpected shapes / workspace (n_in %d, in0 %d, out %d, ws %zu)\n", n_in, n_in > 0 ? in_sizes[0] : -1, out_size, ws_size); grid = -1; return; }
        int dev = 0, cus = 0, per_cu = 0;
        if (hipGetDevice(&dev) != hipSuccess || hipDeviceGetAttribute(&cus, hipDeviceAttributeMultiprocessorCount, dev) != hipSuccess) { grid = -1; return; }
        if (hipFuncSetAttribute((const void*)fwd, hipFuncAttributeMaxDynamicSharedMemorySize, LDS_BYTES) != hipSuccess) { fprintf(stderr, "kernel_launch: hipFuncSetAttribute failed\n"); grid = -1; return; }
        if (hipOccupancyMaxActiveBlocksPerMultiprocessor(&per_cu, (const void*)fwd, NTHR, LDS_BYTES) != hipSuccess || per_cu < 1) { fprintf(stderr, "kernel_launch: occupancy query says %d\n", per_cu); per_cu = 1; }
        (void)hipGetLastError();
        grid = cus * (per_cu > 1 ? 1 : per_cu);
    }
    if (grid < 0) return;
    (void)hipMemsetAsync((char*)d_ws + WS_CTL, 0, CTL_ZERO_BYTES, stream);
    Args a{};
    for (int i = 0; i < 20; ++i) a.in[i] = (const float*)d_in[i];
    a.out = (float*)d_out; a.ws = (unsigned char*)d_ws;
#if MK_ONE_LAUNCH
    a.ph_lo = 0; a.ph_hi = N_PHASES;
    void* kargs[] = {&a};
    hipError_t e = hipLaunchCooperativeKernel((const void*)fwd, dim3(grid), dim3(NTHR), kargs, LDS_BYTES, stream);
    if (e != hipSuccess) fprintf(stderr, "kernel_launch: cooperative launch failed: %s (grid %d)\n", hipGetErrorString(e), grid);
#else
    for (int p = 0; p < N_PHASES; ++p) { a.ph_lo = p; a.ph_hi = p + 1; hipLaunchKernelGGL(fwd, dim3(grid), dim3(NTHR), LDS_BYTES, stream, a); }
#endif
}
```
